# Optimizing an MI355X kernel written in HIP

```python
import math
import jax, jax.numpy as jnp
from jax import lax
import numpy as np

D_MODEL = 1024
BATCH = 8
SEQ = 8192
DEPTH = 1
DEC_BATCH = 16
DEC_SEQ = 32
PAST_LEN = 4096

CHUNK = 64
N_META = 16
CONV_DIM = D_MODEL // 2
CONV_W = 3
N_HEADS = 8
N_KV_HEADS = 2
HEAD_DIM = 64
GROUP = N_HEADS // N_KV_HEADS
Q_DIM = N_HEADS * HEAD_DIM
KV_DIM = N_KV_HEADS * HEAD_DIM
MIX_DIM = CONV_DIM + Q_DIM
IN_DIM = 3 * CONV_DIM + Q_DIM + 2 * KV_DIM
WINDOW = 128
WIN_CHUNKS = WINDOW // CHUNK
N_BUCKETS = 32
MAX_DISTANCE = 128
D_FF = 4 * D_MODEL
EPS = 1e-6
SPLITS = [CONV_DIM, 2 * CONV_DIM, 3 * CONV_DIM, 3 * CONV_DIM + Q_DIM, 3 * CONV_DIM + Q_DIM + KV_DIM]

kernel_name = "hybrid_conv_swa_sink_stream_step"


def rms_norm(x, g):
    xf = x.astype(jnp.float32)
    y = xf * lax.rsqrt(jnp.mean(xf * xf, axis=-1, keepdims=True) + EPS)
    return (y * g.astype(jnp.float32)).astype(x.dtype)


def t5_bucket(rp):
    nb = N_BUCKETS // 2
    max_exact = nb // 2
    ret = jnp.where(rp > 0, nb, 0)
    n = jnp.abs(rp)
    nf = jnp.maximum(n, 1).astype(jnp.float32)
    large = max_exact + (jnp.log(nf / max_exact) / math.log(MAX_DISTANCE / max_exact) * (nb - max_exact)).astype(jnp.int32)
    large = jnp.minimum(large, nb - 1)
    return ret + jnp.where(n < max_exact, n, large)


def rel_bias(table, q_pos, k_pos):
    b = table[t5_bucket(k_pos - q_pos)]
    b = jnp.moveaxis(b, -1, -3)
    return b.reshape(b.shape[:-3] + (N_KV_HEADS, GROUP) + b.shape[-2:]).astype(jnp.float32)


def sink_attention(q, k, v, bias, sinks, mask=None):
    s = jnp.einsum("...qhgd,...khd->...hgqk", q.astype(jnp.float32), k.astype(jnp.float32)) * (HEAD_DIM ** -0.5) + bias
    if mask is not None:
        s = jnp.where(mask, s, -jnp.inf)
    sink = sinks.astype(jnp.float32).reshape(N_KV_HEADS, GROUP, 1, 1)
    m = jnp.maximum(jnp.max(s, axis=-1, keepdims=True), sink)
    p = jnp.exp(s - m)
    denom = jnp.sum(p, axis=-1, keepdims=True) + jnp.exp(sink - m)
    o = jnp.einsum("...hgqk,...khd->...qhgd", p / denom, v.astype(jnp.float32))
    return o.astype(q.dtype)


def causal_conv(up, w, length):
    y = up[:, 0:length] * w[0]
    for j in range(1, CONV_W):
        y = y + up[:, j:j + length] * w[j]
    return y


def in_projection(xn, w_in):
    return jnp.split(xn @ w_in, SPLITS, axis=-1)


def prompt_mixer(xn, w_in, conv_w, sinks, table):
    bsz, L, _ = xn.shape
    b, c, u, q, k, v = in_projection(xn, w_in)
    uc = c * u
    up = jnp.pad(uc, ((0, 0), (CONV_W - 1, 0), (0, 0)))
    y_conv = b * causal_conv(up, conv_w, L)
    conv_state = uc[:, L - (CONV_W - 1):]
    q = q.reshape(bsz, L, N_KV_HEADS, GROUP, HEAD_DIM)
    k = k.reshape(bsz, L, N_KV_HEADS, HEAD_DIM)
    v = v.reshape(bsz, L, N_KV_HEADS, HEAD_DIM)
    km, vm = k[:, :N_META], v[:, :N_META]
    pm = jnp.arange(N_META, dtype=jnp.int32)
    o_meta = sink_attention(q[:, :N_META], km, vm, rel_bias(table, pm[:, None], pm[None, :]), sinks)
    S = L - N_META
    nc = S // CHUNK
    qf = q[:, N_META:].reshape(bsz, nc, CHUNK, N_KV_HEADS, GROUP, HEAD_DIM)

    def band(t):
        tp = jnp.pad(t, ((0, 0), (WIN_CHUNKS * CHUNK, 0), (0, 0), (0, 0)))
        tp = tp.reshape(bsz, nc + WIN_CHUNKS, CHUNK, N_KV_HEADS, HEAD_DIM)
        return jnp.concatenate([tp[:, j:j + nc] for j in range(WIN_CHUNKS + 1)], axis=2)

    def with_meta(tm, t):
        tmb = jnp.broadcast_to(tm[:, None], (bsz, nc) + tm.shape[1:])
        return jnp.concatenate([tmb, band(t)], axis=2)

    kf = with_meta(km, k[:, N_META:])
    vf = with_meta(vm, v[:, N_META:])
    ci = jnp.arange(nc, dtype=jnp.int32)[:, None, None]
    qi = jnp.arange(CHUNK, dtype=jnp.int32)[None, :, None]
    r = jnp.arange((WIN_CHUNKS + 1) * CHUNK, dtype=jnp.int32)[None, None, :]
    frame_k = ci * CHUNK - WIN_CHUNKS * CHUNK + r
    q_pos = N_META + ci * CHUNK + qi
    k_pos = jnp.concatenate([jnp.broadcast_to(pm[None, None, :], (nc, 1, N_META)), N_META + frame_k], axis=-1)
    valid = jnp.concatenate([jnp.ones((nc, 1, N_META), dtype=bool), frame_k >= 0], axis=-1)
    bias = rel_bias(table, q_pos, k_pos)
    o_f = sink_attention(qf, kf, vf, bias, sinks, valid[:, None, None])
    y_attn = jnp.concatenate([o_meta.reshape(bsz, N_META, Q_DIM), o_f.reshape(bsz, S, Q_DIM)], axis=1)
    n_keep = min(WINDOW, S)
    return y_conv, y_attn, k[:, L - n_keep:], v[:, L - n_keep:], km, vm, conv_state


def sample_mixer(xn, w_in, conv_w, sinks, table, ck, cv, cmk, cmv, conv_state):
    bsz, S, _ = xn.shape
    b, c, u, q, k, v = in_projection(xn, w_in)
    uc = c * u
    up = jnp.concatenate([conv_state.astype(uc.dtype), uc], axis=1)
    y_conv = b * causal_conv(up, conv_w, S)
    new_conv = up[:, S:]
    q = q.reshape(bsz, S, N_KV_HEADS, GROUP, HEAD_DIM)
    k = k.reshape(bsz, S, N_KV_HEADS, HEAD_DIM)
    v = v.reshape(bsz, S, N_KV_HEADS, HEAD_DIM)
    n_win = ck.shape[1]
    k_all = jnp.concatenate([cmk.astype(k.dtype), ck.astype(k.dtype), k], axis=1)
    v_all = jnp.concatenate([cmv.astype(v.dtype), cv.astype(v.dtype), v], axis=1)
    q_pos = N_META + PAST_LEN + jnp.arange(S, dtype=jnp.int32)[:, None]
    k_pos = jnp.concatenate([
        jnp.arange(N_META, dtype=jnp.int32),
        N_META + PAST_LEN - n_win + jnp.arange(n_win, dtype=jnp.int32),
        N_META + PAST_LEN + jnp.arange(S, dtype=jnp.int32)])[None, :]
    o = sink_attention(q, k_all, v_all, rel_bias(table, q_pos, k_pos), sinks)
    return y_conv, o.reshape(bsz, S, Q_DIM), k, v, new_conv


def merge(y_conv, y_attn, g_conv, g_attn, w_out):
    return jnp.concatenate([rms_norm(y_conv, g_conv), rms_norm(y_attn, g_attn)], axis=-1) @ w_out


def sq_relu_mlp(x, w_up, w_down):
    h = jax.nn.relu(x @ w_up)
    return (h * h) @ w_down


def setup_inputs(seed: int = 0) -> dict:
    key = jax.random.key(seed)
    ks = jax.random.split(key, 20)
    n_win = min(WINDOW, PAST_LEN)
    f32 = jnp.float32
    nrm = lambda k, s, sc: jax.random.normal(k, s, f32) * sc
    gain = lambda k, s: 1.0 + 0.02 * jax.random.normal(k, s, f32)
    return {
        "x_prompt": nrm(ks[0], (BATCH, SEQ, D_MODEL), 1.0),
        "x_sample": nrm(ks[1], (DEC_BATCH, DEC_SEQ, D_MODEL), 1.0),
        "cache_k": nrm(ks[2], (DEPTH, DEC_BATCH, n_win, N_KV_HEADS, HEAD_DIM), 1.0),
        "cache_v": nrm(ks[3], (DEPTH, DEC_BATCH, n_win, N_KV_HEADS, HEAD_DIM), 1.0),
        "cache_meta_k": nrm(ks[4], (DEPTH, DEC_BATCH, N_META, N_KV_HEADS, HEAD_DIM), 1.0),
        "cache_meta_v": nrm(ks[5], (DEPTH, DEC_BATCH, N_META, N_KV_HEADS, HEAD_DIM), 1.0),
        "state_conv": nrm(ks[6], (DEPTH, DEC_BATCH, CONV_W - 1, CONV_DIM), 1.0),
        "meta_tokens": nrm(ks[7], (N_META, D_MODEL), 1.0),
        "norm_mix": gain(ks[8], (DEPTH, D_MODEL)),
        "w_in": nrm(ks[9], (DEPTH, D_MODEL, IN_DIM), D_MODEL ** -0.5),
        "conv_w": nrm(ks[10], (DEPTH, CONV_W, CONV_DIM), CONV_W ** -0.5),
        "attn_sinks": nrm(ks[11], (DEPTH, N_HEADS), 0.5),
        "rel_bias_table": nrm(ks[12], (N_BUCKETS, N_HEADS), 0.2),
        "norm_conv_out": gain(ks[13], (DEPTH, CONV_DIM)),
        "norm_attn_out": gain(ks[14], (DEPTH, Q_DIM)),
        "w_out": nrm(ks[15], (DEPTH, MIX_DIM, D_MODEL), MIX_DIM ** -0.5),
        "norm_mlp": gain(ks[16], (DEPTH, D_MODEL)),
        "w_up": nrm(ks[17], (DEPTH, D_MODEL, D_FF), D_MODEL ** -0.5),
        "w_down": nrm(ks[18], (DEPTH, D_FF, D_MODEL), D_FF ** -0.5),
        "norm_final": gain(ks[19], (D_MODEL,)),
    }


def reference(x_prompt, x_sample, cache_k, cache_v, cache_meta_k, cache_meta_v, state_conv, meta_tokens,
              norm_mix, w_in, conv_w, attn_sinks, rel_bias_table, norm_conv_out, norm_attn_out, w_out,
              norm_mlp, w_up, w_down, norm_final):
    bsz = x_prompt.shape[0]
    hp = jnp.concatenate([jnp.broadcast_to(meta_tokens.astype(x_prompt.dtype)[None], (bsz, N_META, D_MODEL)), x_prompt], axis=1)
    hs = x_sample
    pk, pv, pmk, pmv, pc, sk, sv, sc = [], [], [], [], [], [], [], []
    for l in range(DEPTH):
        yc, ya, kw, vw, mk, mv, cs = prompt_mixer(rms_norm(hp, norm_mix[l]), w_in[l], conv_w[l], attn_sinks[l], rel_bias_table)
        hp = hp + merge(yc, ya, norm_conv_out[l], norm_attn_out[l], w_out[l])
        hp = hp + sq_relu_mlp(rms_norm(hp, norm_mlp[l]), w_up[l], w_down[l])
        pk.append(kw); pv.append(vw); pmk.append(mk); pmv.append(mv); pc.append(cs)
        yc, ya, kn, vn, cn = sample_mixer(rms_norm(hs, norm_mix[l]), w_in[l], conv_w[l], attn_sinks[l], rel_bias_table,
                                          cache_k[l], cache_v[l], cache_meta_k[l], cache_meta_v[l], state_conv[l])
        hs = hs + merge(yc, ya, norm_conv_out[l], norm_attn_out[l], w_out[l])
        hs = hs + sq_relu_mlp(rms_norm(hs, norm_mlp[l]), w_up[l], w_down[l])
        sk.append(kn); sv.append(vn); sc.append(cn)
    y_prompt = rms_norm(hp, norm_final)[:, N_META:]
    y_sample = rms_norm(hs, norm_final)
    return (y_prompt, y_sample, jnp.stack(pk), jnp.stack(pv), jnp.stack(pmk), jnp.stack(pmv), jnp.stack(pc),
            jnp.stack(sk), jnp.stack(sv), jnp.stack(sc))
```

```cpp
#include <hip/hip_runtime.h>
#include <hip/hip_cooperative_groups.h>
#include <cstdio>
#include <cstdint>
namespace cg = cooperative_groups;
namespace pg8 {
#define PG8_LAS __attribute__((address_space(3)))
typedef unsigned short bf16_t;
typedef short bf16x8 __attribute__((ext_vector_type(8)));
typedef float f32x4 __attribute__((ext_vector_type(4)));
typedef unsigned u32x4 __attribute__((ext_vector_type(4)));
constexpr int BM = 256, BK = 64, HALF = 128, HTB = HALF * BK * 2  , STAGE_BYTES = 8 * HTB, NXCD = 8, WGM = 8;

__host__ __device__ __forceinline__ int lds_byte(int r, int c) { const int st = (r >> 4) * 2 + (c >> 5), rr = r & 15, cc = c & 31, ob = rr * 64 + cc * 2; return st * 1024 + (ob ^ (((ob >> 9) & 1) << 5)); }
__host__ __device__ __forceinline__ void stage_rc(int b, int& R, int& C) { const int st = b / 1024, sb = b % 1024, swz = sb ^ (((sb >> 9) & 1) << 5); R = (st >> 1) * 16 + swz / 64; C = (st & 1) * 32 + (swz % 64) / 2; }
__host__ __device__ __forceinline__ int perm32(int rho) { const int n = rho >> 4, i = rho & 15; return 8 * (i >> 2) + 4 * n + (i & 3); }

struct Unit { int pm, pn; };
struct Gemm { const bf16_t* A; const bf16_t* Bt; int M, N, K; };

struct StaticOrder {
    int nM, nN, nwg, G, c;
    __host__ __device__ void init(int M, int N, int G_, int c_) { nM = M / BM; nN = N / BM; nwg = nM * nN; G = G_; c = c_; }
    __host__ __device__ bool next(int i, Unit& u) const {
        const long L = (long)i * G + c; if (L >= nwg) return false;
        int wgid = (int)L; { const int q = nwg / NXCD, r = nwg % NXCD, xcd = wgid % NXCD, off = wgid / NXCD; wgid = (xcd < r ? xcd * (q + 1) : r * (q + 1) + (xcd - r) * q) + off; }
        const int nig = WGM * nN, gid = wgid / nig, fm = gid * WGM, gsz = (nM - fm) < WGM ? (nM - fm) : WGM;
        u.pm = fm + ((wgid % nig) % gsz); u.pn = (wgid % nig) / gsz; return true;
    }
    __device__ __forceinline__ void a_ready(const Unit&) const {}
    __device__ __forceinline__ void done(const Unit&) const {}
};

__device__ __forceinline__ unsigned cvt_pk_bf16(float lo, float hi) { unsigned r; asm volatile("v_cvt_pk_bf16_f32 %0, %1, %2" : "=v"(r) : "v"(lo), "v"(hi)); return r; }
typedef unsigned u32x2 __attribute__((ext_vector_type(2)));
constexpr float RMS_EPS = 1e-6f;

struct EpiProj {
    static constexpr bool PERM = true, AFTER_DRAIN = false;
    bf16_t* O; int ldc;
    __device__ __forceinline__ void operator()(const f32x4 (&acc)[2][2][4][2], const Unit& u, int wr, int wc, int fr, int fq) const {
        const int row0 = u.pm * BM + wr * 64 + fr, col0 = u.pn * BM + wc * 32 + 8 * fq;
#pragma unroll
        for (int ai = 0; ai < 2; ++ai)
#pragma unroll
            for (int m = 0; m < 4; ++m) { bf16_t* rowp = O + (size_t)(row0 + ai * HALF + m * 16) * ldc + col0;
#pragma unroll
                for (int bj = 0; bj < 2; ++bj) { const f32x4 v0 = acc[ai][bj][m][0], v1 = acc[ai][bj][m][1];
                    u32x4 w; w.x = cvt_pk_bf16(v0[0], v0[1]); w.y = cvt_pk_bf16(v0[2], v0[3]); w.z = cvt_pk_bf16(v1[0], v1[1]); w.w = cvt_pk_bf16(v1[2], v1[3]);
                    *(u32x4*)(rowp + bj * HALF) = w; } }
    }
};
struct EpiUp {
    static constexpr bool PERM = true, AFTER_DRAIN = false;
    bf16_t* O; int ldc; const float* ssq;
    __device__ __forceinline__ void operator()(const f32x4 (&acc)[2][2][4][2], const Unit& u, int wr, int wc, int fr, int fq) const {
        const int row0 = u.pm * BM + wr * 64 + fr, col0 = u.pn * BM + wc * 32 + 8 * fq;
#pragma unroll
        for (int ai = 0; ai < 2; ++ai)
#pragma unroll
            for (int m = 0; m < 4; ++m) { const int row = row0 + ai * HALF + m * 16; bf16_t* rowp = O + (size_t)row * ldc + col0;
                const f32x4* sp = (const f32x4*)(ssq + (size_t)row * 16); const f32x4 s0 = sp[0], s1 = sp[1], s2 = sp[2], s3 = sp[3];
                const float tot = ((s0[0] + s0[1]) + (s0[2] + s0[3])) + ((s1[0] + s1[1]) + (s1[2] + s1[3])) + ((s2[0] + s2[1]) + (s2[2] + s2[3])) + ((s3[0] + s3[1]) + (s3[2] + s3[3]));
                const float rs = 1.0f / sqrtf(tot * (1.0f / 1024.0f) + RMS_EPS);
#pragma unroll
                for (int bj = 0; bj < 2; ++bj) { f32x4 v0 = acc[ai][bj][m][0] * rs, v1 = acc[ai][bj][m][1] * rs;
#pragma unroll
                    for (int e = 0; e < 4; ++e) { v0[e] = fmaxf(v0[e], 0.f); v0[e] *= v0[e]; v1[e] = fmaxf(v1[e], 0.f); v1[e] *= v1[e]; }
                    u32x4 w; w.x = cvt_pk_bf16(v0[0], v0[1]); w.y = cvt_pk_bf16(v0[2], v0[3]); w.z = cvt_pk_bf16(v1[0], v1[1]); w.w = cvt_pk_bf16(v1[2], v1[3]);
                    *(u32x4*)(rowp + bj * HALF) = w; } }
    }
};
struct EpiOut {
    static constexpr bool PERM = false, AFTER_DRAIN = false;
    const float* xp; const float* xs; float* out; bf16_t* xn; float* ssq; int nprompt;
    __device__ __forceinline__ void operator()(const f32x4 (&acc)[2][2][4][2], const Unit& u, int wr, int wc, int fr, int fq) const {
        const int col0 = u.pn * BM + wc * 32 + 4 * fq;
#pragma unroll
        for (int ai = 0; ai < 2; ++ai)
#pragma unroll
            for (int m = 0; m < 4; ++m) { const int row = u.pm * BM + ai * HALF + wr * 64 + m * 16 + fr;
                const float* base = (row < nprompt) ? xp + (size_t)row * 1024 : xs + (size_t)(row - nprompt) * 1024;
                float q = 0.f;
#pragma unroll
                for (int bj = 0; bj < 2; ++bj)
#pragma unroll
                    for (int n = 0; n < 2; ++n) { const int c = col0 + bj * HALF + n * 16; const f32x4 h = *(const f32x4*)(base + c) + acc[ai][bj][m][n];
                        *(f32x4*)(out + (size_t)row * 1024 + c) = h; u32x2 w; w.x = cvt_pk_bf16(h[0], h[1]); w.y = cvt_pk_bf16(h[2], h[3]); *(u32x2*)(xn + (size_t)row * 1024 + c) = w;
                        q += (h[0] * h[0] + h[1] * h[1]) + (h[2] * h[2] + h[3] * h[3]); }
                q += __shfl_xor(q, 16); q += __shfl_xor(q, 32);
                if (fq == 0) ssq[(size_t)row * 16 + u.pn * 4 + wc] = q; }
    }
};
struct EpiDown {
    static constexpr bool PERM = false, AFTER_DRAIN = false;
    float* out;
    __device__ __forceinline__ void operator()(const f32x4 (&acc)[2][2][4][2], const Unit& u, int wr, int wc, int fr, int fq) const {
        const int col0 = u.pn * BM + wc * 32 + 4 * fq;
#pragma unroll
        for (int ai = 0; ai < 2; ++ai)
#pragma unroll
            for (int m = 0; m < 4; ++m) { const int row = u.pm * BM + ai * HALF + wr * 64 + m * 16 + fr; float* rowp = out + (size_t)row * 1024 + col0;
#pragma unroll
                for (int bj = 0; bj < 2; ++bj)
#pragma unroll
                    for (int n = 0; n < 2; ++n) { float* p = rowp + bj * HALF + n * 16; *(f32x4*)p = *(const f32x4*)p + acc[ai][bj][m][n]; } }
    }
};

template <class Epi, class Sched, bool ALIGN_EPI = false, bool SP2 = false>
__device__ __forceinline__ void gemm_phase(PG8_LAS unsigned char* lds, const Gemm g, const Sched& S, const Epi& E) {
    const int tid = threadIdx.x, wid = __builtin_amdgcn_readfirstlane(tid >> 6), lane = tid & 63, wr = wid >> 2, wc = wid & 3, fr = lane & 15, fq = lane >> 4;
    const int K = g.K, nt = K / BK;
    unsigned voffA[2], voffB[2];
#pragma unroll
    for (int i = 0; i < 2; ++i) { int R, C; stage_rc(tid * 16 + i * 8192, R, C); const int Rb = Epi::PERM ? ((R & ~31) + perm32(R & 31)) : R;
        voffA[i] = (unsigned)(R * K + C) * 2u; voffB[i] = (unsigned)(Rb * K + C) * 2u; }
    const size_t kstep = (size_t)(BK * 2);
    const size_t hstep = (size_t)HALF * K * 2;
    const size_t tstep = 2 * hstep;
    const unsigned ldsw = (unsigned)wid * 1024u;
    const int aoff = lds_byte(wr * 64 + fr, fq * 8), boff = lds_byte(wc * 32 + fr, fq * 8);
#define PG8_SA(b, h) (((b) * 2 + (h)) * HTB)
#define PG8_SB(b, h) ((4 + (b) * 2 + (h)) * HTB)
#define PG8_STAGE(bufoff, gbase, voff) do { _Pragma("unroll") for (int _i = 0; _i < 2; ++_i) \
        __builtin_amdgcn_global_load_lds((const unsigned*)((const char*)(gbase) + (voff)[_i]), (PG8_LAS unsigned*)(lds + (bufoff) + ldsw + _i * 8192), 16, 0, 0); } while (0)
#define PG8_LDA(dst, b, h) do { _Pragma("unroll") for (int m = 0; m < 4; ++m) _Pragma("unroll") for (int k = 0; k < 2; ++k) dst[m][k] = *(const PG8_LAS bf16x8*)(lds + PG8_SA(b, h) + aoff + m * 2048 + k * 1024); } while (0)
#define PG8_LDB(dst, b, h) do { _Pragma("unroll") for (int n = 0; n < 2; ++n) _Pragma("unroll") for (int k = 0; k < 2; ++k) dst[n][k] = *(const PG8_LAS bf16x8*)(lds + PG8_SB(b, h) + boff + n * 2048 + k * 1024); } while (0)
#define PG8_MMA(ai, bj, At, Bt) do { __builtin_amdgcn_s_setprio(1); _Pragma("unroll") for (int m = 0; m < 4; ++m) _Pragma("unroll") for (int n = 0; n < 2; ++n) _Pragma("unroll") for (int k = 0; k < 2; ++k) \
        acc[ai][bj][m][n] = __builtin_amdgcn_mfma_f32_16x16x32_bf16(Bt[n][k], At[m][k], acc[ai][bj][m][n], 0, 0, 0); __builtin_amdgcn_s_setprio(0); } while (0)
#define PG8_WAIT_V(n) asm volatile("s_waitcnt vmcnt(" #n ")" ::: "memory")
#define PG8_WAIT_L(n) asm volatile("s_waitcnt lgkmcnt(" #n ")" ::: "memory")
#define PG8_BAR __builtin_amdgcn_s_barrier()
#define PG8_SCHED __builtin_amdgcn_sched_barrier(0)
    Unit cur, nxt; int ui = 0;
    if (!S.next(0, cur)) return;
    f32x4 acc[2][2][4][2];
#pragma unroll
    for (int a = 0; a < 2; ++a)
#pragma unroll
        for (int b = 0; b < 2; ++b)
#pragma unroll
            for (int m = 0; m < 4; ++m)
#pragma unroll
                for (int n = 0; n < 2; ++n) acc[a][b][m][n] = (f32x4){0.f, 0.f, 0.f, 0.f};
    bf16x8 At[4][2], B0[2][2], B1[2][2];
    const char* cA = (const char*)g.A + (size_t)cur.pm * tstep; const char* cB = (const char*)g.Bt + (size_t)cur.pn * tstep;
    S.a_ready(cur);
    if constexpr (SP2) {
        PG8_STAGE(PG8_SB(0, 0), cB, voffB); PG8_STAGE(PG8_SB(0, 1), cB + hstep, voffB); PG8_STAGE(PG8_SA(0, 0), cA, voffA); PG8_STAGE(PG8_SA(0, 1), cA + hstep, voffA);
        if (wr == 1) PG8_BAR;
        PG8_WAIT_V(2); PG8_BAR;
        PG8_STAGE(PG8_SB(1, 0), cB + kstep, voffB); PG8_STAGE(PG8_SA(1, 0), cA + kstep, voffA); PG8_STAGE(PG8_SB(1, 1), cB + hstep + kstep, voffB);
        PG8_WAIT_V(6); PG8_BAR;
    } else {
        PG8_STAGE(PG8_SB(0, 0), cB, voffB); PG8_STAGE(PG8_SA(0, 0), cA, voffA); PG8_STAGE(PG8_SB(0, 1), cB + hstep, voffB); PG8_STAGE(PG8_SA(0, 1), cA + hstep, voffA);
        if (wr == 1) PG8_BAR;
        PG8_WAIT_V(4); PG8_BAR;
        PG8_STAGE(PG8_SB(1, 0), cB + kstep, voffB); PG8_STAGE(PG8_SA(1, 0), cA + kstep, voffA); PG8_STAGE(PG8_SB(1, 1), cB + hstep + kstep, voffB);
        PG8_WAIT_V(6); PG8_BAR;
    }
    for (;;) {
        const bool has_next = S.next(ui + 1, nxt);
        const char* nA = has_next ? (const char*)g.A + (size_t)nxt.pm * tstep : cA; const char* nB = has_next ? (const char*)g.Bt + (size_t)nxt.pn * tstep : cB;
        for (int t = 0; t < nt; t += 2) {
            const bool last = (t == nt - 2);
            const char* a1 = cA + (size_t)(t + 1) * kstep;
            const char* a2 = last ? nA : cA + (size_t)(t + 2) * kstep; const char* b2 = last ? nB : cB + (size_t)(t + 2) * kstep;
            const char* a3 = a2 + kstep; const char* b3 = b2 + kstep;
            if (last && has_next) S.a_ready(nxt);
            if constexpr (SP2) {
            PG8_LDB(B0, 0, 0); PG8_LDB(B1, 0, 1); PG8_SCHED; PG8_LDA(At, 0, 0); PG8_STAGE(PG8_SA(1, 1), a1 + hstep, voffA);
            PG8_WAIT_V(8); PG8_WAIT_L(0); PG8_BAR; PG8_MMA(0, 0, At, B0); PG8_MMA(0, 1, At, B1); PG8_BAR; PG8_SCHED;
            PG8_LDA(At, 0, 1); PG8_STAGE(PG8_SB(0, 0), b2, voffB); PG8_STAGE(PG8_SB(0, 1), b2 + hstep, voffB); PG8_STAGE(PG8_SA(0, 0), a2, voffA);
            PG8_WAIT_V(8); PG8_WAIT_L(0); PG8_BAR; PG8_MMA(1, 0, At, B0); PG8_MMA(1, 1, At, B1); PG8_BAR; PG8_SCHED;
            PG8_LDB(B0, 1, 0); PG8_LDB(B1, 1, 1); PG8_SCHED; PG8_LDA(At, 1, 0); PG8_STAGE(PG8_SA(0, 1), a2 + hstep, voffA);
            PG8_WAIT_V(8); PG8_WAIT_L(0); PG8_BAR; PG8_MMA(0, 0, At, B0); PG8_MMA(0, 1, At, B1); PG8_BAR; PG8_SCHED;
            PG8_LDA(At, 1, 1); PG8_STAGE(PG8_SB(1, 0), b3, voffB); PG8_STAGE(PG8_SB(1, 1), b3 + hstep, voffB); PG8_STAGE(PG8_SA(1, 0), a3, voffA);
            PG8_WAIT_V(8); PG8_WAIT_L(0); PG8_BAR; PG8_MMA(1, 0, At, B0); PG8_MMA(1, 1, At, B1); PG8_BAR; PG8_SCHED;
            } else {
            PG8_LDB(B0, 0, 0); PG8_SCHED; PG8_LDA(At, 0, 0); PG8_STAGE(PG8_SA(1, 1), a1 + hstep, voffA);
            PG8_WAIT_L(8); PG8_BAR; PG8_WAIT_L(0); PG8_MMA(0, 0, At, B0); PG8_BAR; PG8_SCHED;
            PG8_LDB(B1, 0, 1); PG8_STAGE(PG8_SB(0, 0), b2, voffB);
            PG8_BAR; PG8_WAIT_L(0); PG8_MMA(0, 1, At, B1); PG8_BAR;
            PG8_LDA(At, 0, 1); PG8_STAGE(PG8_SA(0, 0), a2, voffA);
            PG8_BAR; PG8_WAIT_L(0); PG8_MMA(1, 0, At, B0); PG8_BAR; PG8_SCHED;
            PG8_STAGE(PG8_SB(0, 1), b2 + hstep, voffB);
            PG8_WAIT_V(6); PG8_BAR; PG8_MMA(1, 1, At, B1); PG8_BAR;
            PG8_LDB(B0, 1, 0); PG8_SCHED; PG8_LDA(At, 1, 0); PG8_STAGE(PG8_SA(0, 1), a2 + hstep, voffA);
            PG8_WAIT_L(8); PG8_BAR; PG8_WAIT_L(0); PG8_MMA(0, 0, At, B0); PG8_BAR; PG8_SCHED;
            PG8_LDB(B1, 1, 1); PG8_STAGE(PG8_SB(1, 0), b3, voffB);
            PG8_BAR; PG8_WAIT_L(0); PG8_MMA(0, 1, At, B1); PG8_BAR;
            PG8_LDA(At, 1, 1); PG8_STAGE(PG8_SA(1, 0), a3, voffA);
            PG8_BAR; PG8_WAIT_L(0); PG8_MMA(1, 0, At, B0); PG8_BAR; PG8_SCHED;
            PG8_STAGE(PG8_SB(1, 1), b3 + hstep, voffB);
            PG8_WAIT_V(6); PG8_BAR; PG8_MMA(1, 1, At, B1); PG8_BAR;
            }
        }
        if constexpr (ALIGN_EPI) { if (wr == 0) PG8_BAR; }
        if constexpr (!Epi::AFTER_DRAIN) { E(acc, cur, wr, wc, fr, fq); S.done(cur); }
        if (!has_next) break;
#pragma unroll
        for (int a = 0; a < 2; ++a)
#pragma unroll
            for (int b = 0; b < 2; ++b)
#pragma unroll
                for (int m = 0; m < 4; ++m)
#pragma unroll
                    for (int n = 0; n < 2; ++n) acc[a][b][m][n] = (f32x4){0.f, 0.f, 0.f, 0.f};
        cur = nxt; cA = nA; cB = nB; ++ui;
        if constexpr (ALIGN_EPI) { if (wr == 1) PG8_BAR; }
    }
    PG8_WAIT_V(0);
    if constexpr (!ALIGN_EPI) { if (wr == 0) PG8_BAR; }
    PG8_BAR;
    if constexpr (Epi::AFTER_DRAIN) { E.fused(acc, cur, wr, wc, fr, fq, lds, wid, lane); S.done(cur); }
#undef PG8_SA
#undef PG8_SB
#undef PG8_STAGE
#undef PG8_LDA
#undef PG8_LDB
#undef PG8_MMA
#undef PG8_WAIT_V
#undef PG8_WAIT_L
#undef PG8_BAR
#undef PG8_SCHED
}
}

constexpr int D = 1024, NIN = 2304, FF = 4096;
constexpr int NB = 8, SEQ = 8192, NPROMPT = NB * SEQ;
constexpr int SB = 16, SS = 32, NSAMP = SB * SS;
constexpr int MTOT = NPROMPT + NSAMP;
constexpr int NMETA = 16, CONVD = 512, QD = 512, KVD = 128, HD = 64;
constexpr int COL_B = 0, COL_C = 512, COL_U = 1024, COL_Q = 1536, COL_K = 2048, COL_V = 2176;
constexpr float EPS = 1e-6f;
constexpr float LOG2E = 1.4426950408889634f;
constexpr float C2 = 0.125f * LOG2E;
constexpr size_t O_YP = 0, O_YS = 67108864, O_PK = 67633152, O_PV = 67764224, O_PMK = 67895296, O_PMV = 67911680, O_PC = 67928064, O_SK = 67936256, O_SV = 68001792, O_SC = 68067328, O_END = 68083712;
constexpr size_t MiB = 1u << 20;
constexpr size_t WS_WIN = 2 * MiB, WS_WOUT = 8 * MiB, WS_WUP = 10 * MiB, WS_WDN = 18 * MiB;
constexpr size_t WS_METAPROJ = 26 * MiB;
constexpr size_t WS_METAKV = 26 * MiB + 256 * 1024;
constexpr size_t WS_SSQ = 27 * MiB;
constexpr size_t WS_XN2 = 32 * MiB;
constexpr size_t WS_XN0 = 161 * MiB;
constexpr size_t WS_PROJ = 290 * MiB;
constexpr size_t WS_MIX = 581 * MiB;
constexpr size_t WS_HID = 161 * MiB;
constexpr size_t WS_END = 710 * MiB;
static_assert(WS_SSQ + (size_t)MTOT * 16 * 4 <= WS_XN2 && WS_XN2 + (size_t)MTOT * D * 2 <= WS_XN0 && WS_XN0 + (size_t)MTOT * D * 2 <= WS_PROJ && WS_PROJ + (size_t)MTOT * NIN * 2 <= WS_MIX && WS_MIX + (size_t)MTOT * D * 2 <= WS_END && WS_HID + (size_t)MTOT * FF * 2 <= WS_END, "ws map");

constexpr int NWAVES = 8, NTHREADS = 512;
constexpr int LDS_BYTES = 147456;

#define LAS __attribute__((address_space(3)))
typedef unsigned short bf16;
typedef unsigned v4u __attribute__((ext_vector_type(4)));
typedef float f32x4 __attribute__((ext_vector_type(4)));

__device__ __forceinline__ unsigned f2bf(float f) { unsigned u = __builtin_bit_cast(unsigned, f); return (u + 0x7fffu + ((u >> 16) & 1u)) >> 16; }
__device__ __forceinline__ unsigned pk2(float lo, float hi) { return f2bf(lo) | (f2bf(hi) << 16); }
__device__ __forceinline__ float bflo(unsigned w) { return __builtin_bit_cast(float, w << 16); }
__device__ __forceinline__ float bfhi(unsigned w) { return __builtin_bit_cast(float, w & 0xffff0000u); }
__device__ __forceinline__ float wave_sum(float v) {
#pragma unroll
    for (int o = 1; o < 64; o <<= 1) v += __shfl_xor(v, o);
    return v;
}

struct Params {
    const float* in[20];
    float* out;
    unsigned char* ws;
};

__device__ __forceinline__ void p0_transpose_item(const float* W, int K, int N, bf16* WT, const float* gk, LAS float* scr, int item, int lane) {
    const int nblk = N / 32, kb = item / nblk, nb = item % nblk, k0 = 64 * kb, n0 = 32 * nb;
#pragma unroll 8
    for (int i = 0; i < 32; ++i) { const int kk = 2 * i + (lane >> 5); float v = W[(size_t)(k0 + kk) * N + n0 + (lane & 31)]; if (gk) v *= gk[k0 + kk]; scr[kk * 33 + (lane & 31)] = v; }
    asm volatile("s_waitcnt lgkmcnt(0)" ::: "memory");
    const int c = lane & 7;
#pragma unroll
    for (int j = 0; j < 4; ++j) { const int n = (lane >> 3) + 8 * j; const LAS float* s = scr + (8 * c) * 33 + n;
        v4u o; o.x = pk2(s[0 * 33], s[1 * 33]); o.y = pk2(s[2 * 33], s[3 * 33]); o.z = pk2(s[4 * 33], s[5 * 33]); o.w = pk2(s[6 * 33], s[7 * 33]);
        *(v4u*)(WT + (size_t)(n0 + n) * K + k0 + 8 * c) = o; }
    asm volatile("s_waitcnt lgkmcnt(0)" ::: "memory");
}
__device__ __forceinline__ void rms_row_to_bf16(const float* xrow, const float* g, bf16* orow, int lane) {
    const f32x4* xr = (const f32x4*)xrow + lane; const f32x4* gr = (const f32x4*)g + lane;
    f32x4 v[4]; float s = 0.f;
#pragma unroll
    for (int j = 0; j < 4; ++j) { v[j] = xr[64 * j]; s += (v[j].x * v[j].x + v[j].y * v[j].y) + (v[j].z * v[j].z + v[j].w * v[j].w); }
    const float rstd = 1.0f / sqrtf(wave_sum(s) * (1.f / D) + EPS);
    unsigned long long* o8 = (unsigned long long*)orow + lane;
#pragma unroll
    for (int j = 0; j < 4; ++j) { const f32x4 gg = gr[64 * j];
        o8[64 * j] = (unsigned long long)pk2(v[j].x * rstd * gg.x, v[j].y * rstd * gg.y) | ((unsigned long long)pk2(v[j].z * rstd * gg.z, v[j].w * rstd * gg.w) << 32); }
}

__device__ __forceinline__ int t5_bucket(int rel) {
    const int n = rel < 0 ? -rel : rel; int ret = rel > 0 ? 16 : 0;
    if (n < 8) return ret + n;
    int large = (31 - __clz(n * n)) + 2; if (large > 15) large = 15;
    return ret + large;
}

__global__ void __launch_bounds__(NTHREADS, 2) fwd_kernel(Params p) {
    extern __shared__ __attribute__((aligned(16))) unsigned char lds_raw[];
    cg::grid_group grid = cg::this_grid();
    LAS unsigned char* lds = (LAS unsigned char*)lds_raw;
    const int tid = threadIdx.x, lane = tid & 63, wave = __builtin_amdgcn_readfirstlane(tid >> 6);
    const int G = gridDim.x, bid = blockIdx.x;
    unsigned char* ws = p.ws;
    const float* x_prompt = p.in[0]; const float* x_sample = p.in[1];
    const float* cache_k = p.in[2]; const float* cache_v = p.in[3]; const float* cache_mk = p.in[4]; const float* cache_mv = p.in[5];
    const float* state_conv = p.in[6]; const float* meta_tokens = p.in[7]; const float* g_mix = p.in[8]; const float* w_in = p.in[9];
    const float* conv_w = p.in[10]; const float* sinks = p.in[11]; const float* rel_table = p.in[12]; const float* g_conv = p.in[13];
    const float* g_attn = p.in[14]; const float* w_out = p.in[15]; const float* g_mlp = p.in[16]; const float* w_up = p.in[17];
    const float* w_down = p.in[18]; const float* g_final = p.in[19];
    float* out = p.out;
    bf16* WinT = (bf16*)(ws + WS_WIN); bf16* WoutT = (bf16*)(ws + WS_WOUT); bf16* WupT = (bf16*)(ws + WS_WUP); bf16* WdnT = (bf16*)(ws + WS_WDN);
    float* METAPROJ = (float*)(ws + WS_METAPROJ); bf16* METAKV = (bf16*)(ws + WS_METAKV); float* SSQ = (float*)(ws + WS_SSQ);
    bf16* XN0 = (bf16*)(ws + WS_XN0); bf16* PROJ = (bf16*)(ws + WS_PROJ); bf16* MIX = (bf16*)(ws + WS_MIX); bf16* XN2 = (bf16*)(ws + WS_XN2); bf16* HID = (bf16*)(ws + WS_HID);

    {
        if (bid < NIN / 64) {
            LAS float* xnT = (LAS float*)lds;
            LAS float* red = (LAS float*)(lds + 65536);
            for (int rr = 0; rr < 2; ++rr) { const int r = 2 * wave + rr; const f32x4* xr = (const f32x4*)(meta_tokens + (size_t)r * D) + lane; const f32x4* gr = (const f32x4*)g_mix + lane;
                f32x4 v[4]; float s = 0.f;
#pragma unroll
                for (int j = 0; j < 4; ++j) { v[j] = xr[64 * j]; s += (v[j].x * v[j].x + v[j].y * v[j].y) + (v[j].z * v[j].z + v[j].w * v[j].w); }
                const float rstd = 1.0f / sqrtf(wave_sum(s) * (1.f / D) + EPS);
#pragma unroll
                for (int j = 0; j < 4; ++j) { const f32x4 gg = gr[64 * j]; const int k = 4 * lane + 256 * j;
                    xnT[(k + 0) * 16 + r] = v[j].x * rstd * gg.x; xnT[(k + 1) * 16 + r] = v[j].y * rstd * gg.y; xnT[(k + 2) * 16 + r] = v[j].z * rstd * gg.z; xnT[(k + 3) * 16 + r] = v[j].w * rstd * gg.w; } }
            __syncthreads();
            const int n = 64 * bid + lane; float acc[16];
#pragma unroll
            for (int r = 0; r < 16; ++r) acc[r] = 0.f;
            for (int k = 128 * wave; k < 128 * wave + 128; ++k) { const float wv = w_in[(size_t)k * NIN + n]; const LAS f32x4* xs = (const LAS f32x4*)(xnT + k * 16);
#pragma unroll
                for (int q = 0; q < 4; ++q) { const f32x4 xv = xs[q]; acc[4 * q + 0] += xv.x * wv; acc[4 * q + 1] += xv.y * wv; acc[4 * q + 2] += xv.z * wv; acc[4 * q + 3] += xv.w * wv; } }
#pragma unroll
            for (int r = 0; r < 16; ++r) red[(wave * 16 + r) * 64 + lane] = acc[r];
            __syncthreads();
            for (int o = tid; o < 1024; o += NTHREADS) { const int r = o >> 6, l = o & 63; float s = 0.f;
#pragma unroll
                for (int w = 0; w < 8; ++w) s += red[(w * 16 + r) * 64 + l];
                const int nn = 64 * bid + l; METAPROJ[r * NIN + nn] = s;
                if (nn >= COL_K) { const int kc = nn - COL_K; METAKV[r * 256 + kc] = (bf16)f2bf(s);
                    float* dst = (kc < 128) ? out + O_PMK + r * 128 + kc : out + O_PMV + r * 128 + (kc - 128);
#pragma unroll
                    for (int b = 0; b < NB; ++b) dst[(size_t)b * NMETA * 128] = s; } }
            __syncthreads();
        }
        LAS float* scr = (LAS float*)(lds + wave * 16384);
        const int gw = bid * NWAVES + wave, NGW = G * NWAVES;
        constexpr int I_IN = (D / 64) * (NIN / 32), I_OUT = (D / 64) * (D / 32), I_UP = (D / 64) * (FF / 32), I_DN = (FF / 64) * (D / 32);
        constexpr int NITEMS = I_IN + I_OUT + I_UP + I_DN;
        for (int it = gw; it < NITEMS; it += NGW) {
            int r = it;
            if (r < I_IN) { p0_transpose_item(w_in, D, NIN, WinT, nullptr, scr, r, lane); continue; } r -= I_IN;
            if (r < I_OUT) { p0_transpose_item(w_out, D, D, WoutT, nullptr, scr, r, lane); continue; } r -= I_OUT;
            if (r < I_UP) { p0_transpose_item(w_up, D, FF, WupT, g_mlp, scr, r, lane); continue; } r -= I_UP;
            p0_transpose_item(w_down, FF, D, WdnT, nullptr, scr, r, lane);
        }
        for (int m = gw; m < MTOT; m += NGW) {
            const float* xrow = (m < NPROMPT) ? x_prompt + (size_t)m * D : x_sample + (size_t)(m - NPROMPT) * D;
            rms_row_to_bf16(xrow, g_mix, XN0 + (size_t)m * D, lane);
        }
    }
    grid.sync();

    {
        pg8::Gemm g{XN0, WinT, MTOT, NIN, D}; pg8::StaticOrder S; S.init(MTOT, NIN, G, bid);
        pg8::EpiProj E{PROJ, NIN};
        pg8::gemm_phase<pg8::EpiProj, pg8::StaticOrder, true, true>(lds, g, S, E);
    }
    grid.sync();

    {
        LAS unsigned char* KV = lds;
        LAS float* BREL = (LAS float*)(lds + 106496);
        LAS float* SSQX = (LAS float*)(lds + 106496 + 8192);
        for (int o = tid; o < 8 * 256; o += NTHREADS) { const int h = o >> 8, idx = o & 255; const int rel = idx - 191; BREL[o] = (idx < 255) ? rel_table[t5_bucket(rel) * 8 + h] * LOG2E : 0.f; }
        __syncthreads();
        const int NUNITS = NB * (SEQ / 64) + SB;
        for (int u = bid; u < NUNITS; u += G) {
            const bool isA = u < NB * (SEQ / 64);
            const int b = isA ? u / (SEQ / 64) : u - NB * (SEQ / 64);
            const int c = isA ? u % (SEQ / 64) : 0;
            const int ntok = isA ? 64 : 32, nwin = isA ? 192 : 160, nk = nwin + 16;
            const size_t row0 = isA ? (size_t)b * SEQ + 64 * c : (size_t)NPROMPT + 32 * b;
            for (int ch = tid; ch < nk * 32; ch += NTHREADS) { const int j = ch >> 5, cc = ch & 31;
                v4u val = (v4u){0u, 0u, 0u, 0u};
                if (isA) {
                    if (j < 192) { const int tk = 64 * (c - 2) + j; if (tk >= 0) val = *(const v4u*)(PROJ + ((size_t)b * SEQ + tk) * NIN + COL_K + 8 * cc); }
                    else val = *(const v4u*)(METAKV + (j - 192) * 256 + 8 * cc);
                } else {
                    const float* src = nullptr;
                    if (j < 128) src = (cc < 16 ? cache_k : cache_v) + ((size_t)b * 128 + j) * 128 + 8 * (cc & 15);
                    else if (j >= 160) src = (cc < 16 ? cache_mk : cache_mv) + ((size_t)b * 16 + (j - 160)) * 128 + 8 * (cc & 15);
                    if (src) { const f32x4 a = *(const f32x4*)src, bb = *(const f32x4*)(src + 4); val.x = pk2(a.x, a.y); val.y = pk2(a.z, a.w); val.z = pk2(bb.x, bb.y); val.w = pk2(bb.z, bb.w); }
                    else val = *(const v4u*)(PROJ + (row0 + (j - 128)) * NIN + COL_K + 8 * cc);
                }
                *(LAS v4u*)(KV + j * 512 + cc * 16) = val; }
            __syncthreads();
            if (isA) { if (c >= 126) { for (int o = tid; o < 64 * 256; o += NTHREADS) { const int i = o >> 8, col = o & 255; const unsigned short hv = *(const LAS unsigned short*)(KV + (128 + i) * 512 + col * 2);
                    const float v = __builtin_bit_cast(float, (unsigned)hv << 16); const int t = 64 * (c - 126) + i;
                    if (col < 128) out[O_PK + ((size_t)b * 128 + t) * 128 + col] = v; else out[O_PV + ((size_t)b * 128 + t) * 128 + (col - 128)] = v; } } }
            else { for (int o = tid; o < 32 * 256; o += NTHREADS) { const int i = o >> 8, col = o & 255; const unsigned short hv = *(const LAS unsigned short*)(KV + (128 + i) * 512 + col * 2);
                    const float v = __builtin_bit_cast(float, (unsigned)hv << 16);
                    if (col < 128) out[O_SK + ((size_t)b * 32 + i) * 128 + col] = v; else out[O_SV + ((size_t)b * 32 + i) * 128 + (col - 128)] = v; } }
            {
                const int h = wave, kvh = h >> 2, i = isA ? lane : (lane & 31);
                const size_t row = row0 + i;
                float qf[64], o[64];
                { const v4u* qp = (const v4u*)(PROJ + row * NIN + COL_Q + 64 * h);
#pragma unroll
                  for (int c8 = 0; c8 < 8; ++c8) { const v4u w = qp[c8]; qf[8 * c8 + 0] = bflo(w.x); qf[8 * c8 + 1] = bfhi(w.x); qf[8 * c8 + 2] = bflo(w.y); qf[8 * c8 + 3] = bfhi(w.y); qf[8 * c8 + 4] = bflo(w.z); qf[8 * c8 + 5] = bfhi(w.z); qf[8 * c8 + 6] = bflo(w.w); qf[8 * c8 + 7] = bfhi(w.w); } }
#pragma unroll
                for (int d = 0; d < 64; ++d) o[d] = 0.f;
                float m = sinks[h] * LOG2E, l = 1.f;
                const int j0 = isA ? (c >= 2 ? 0 : 128 - 64 * c) : 0;
                const int metaoff = isA ? 16 + 64 * c : 16 + 4096;
                for (int j = j0; j < nk; ++j) {
                    int rel = (j < nwin) ? (j - 128 - i) : (j - nwin - metaoff - i); rel = rel < -191 ? -191 : rel;
                    const float bias = BREL[h * 256 + rel + 191];
                    const LAS v4u* kp = (const LAS v4u*)(KV + j * 512 + kvh * 128);
                    float s = 0.f;
#pragma unroll
                    for (int c8 = 0; c8 < 8; ++c8) { const v4u w = kp[c8];
                        s += qf[8 * c8 + 0] * bflo(w.x) + qf[8 * c8 + 1] * bfhi(w.x) + qf[8 * c8 + 2] * bflo(w.y) + qf[8 * c8 + 3] * bfhi(w.y) + qf[8 * c8 + 4] * bflo(w.z) + qf[8 * c8 + 5] * bfhi(w.z) + qf[8 * c8 + 6] * bflo(w.w) + qf[8 * c8 + 7] * bfhi(w.w); }
                    s = s * C2 + bias;
                    const float mn = fmaxf(m, s), sc = __builtin_amdgcn_exp2f(m - mn), pr = __builtin_amdgcn_exp2f(s - mn);
                    l = l * sc + pr; m = mn;
                    const LAS v4u* vp = (const LAS v4u*)(KV + j * 512 + 256 + kvh * 128);
#pragma unroll
                    for (int c8 = 0; c8 < 8; ++c8) { const v4u w = vp[c8];
                        o[8 * c8 + 0] = o[8 * c8 + 0] * sc + pr * bflo(w.x); o[8 * c8 + 1] = o[8 * c8 + 1] * sc + pr * bfhi(w.x); o[8 * c8 + 2] = o[8 * c8 + 2] * sc + pr * bflo(w.y); o[8 * c8 + 3] = o[8 * c8 + 3] * sc + pr * bfhi(w.y);
                        o[8 * c8 + 4] = o[8 * c8 + 4] * sc + pr * bflo(w.z); o[8 * c8 + 5] = o[8 * c8 + 5] * sc + pr * bfhi(w.z); o[8 * c8 + 6] = o[8 * c8 + 6] * sc + pr * bflo(w.w); o[8 * c8 + 7] = o[8 * c8 + 7] * sc + pr * bfhi(w.w); }
                }
                const float inv = 1.0f / l; float ss = 0.f;
#pragma unroll
                for (int d = 0; d < 64; ++d) { o[d] *= inv; ss += o[d] * o[d]; }
                SSQX[h * 64 + i] = ss;
                __syncthreads();
                float tot = 0.f;
#pragma unroll
                for (int hh = 0; hh < 8; ++hh) tot += SSQX[hh * 64 + i];
                const float rstd = 1.0f / sqrtf(tot * (1.f / QD) + EPS);
                if (lane < ntok) { v4u* mp = (v4u*)(MIX + row * D + CONVD + 64 * h); const f32x4* gp = (const f32x4*)(g_attn + 64 * h);
#pragma unroll
                    for (int c8 = 0; c8 < 8; ++c8) { const f32x4 g0 = gp[2 * c8], g1 = gp[2 * c8 + 1]; v4u w;
                        w.x = pk2(o[8 * c8 + 0] * rstd * g0.x, o[8 * c8 + 1] * rstd * g0.y); w.y = pk2(o[8 * c8 + 2] * rstd * g0.z, o[8 * c8 + 3] * rstd * g0.w);
                        w.z = pk2(o[8 * c8 + 4] * rstd * g1.x, o[8 * c8 + 5] * rstd * g1.y); w.w = pk2(o[8 * c8 + 6] * rstd * g1.z, o[8 * c8 + 7] * rstd * g1.w); mp[c8] = w; } }
            }
            {
                const int tpw = ntok / 8, ch = 8 * lane;
                float w0[8], w1[8], w2[8], gc[8];
#pragma unroll
                for (int e = 0; e < 8; ++e) { w0[e] = conv_w[ch + e]; w1[e] = conv_w[CONVD + ch + e]; w2[e] = conv_w[2 * CONVD + ch + e]; gc[e] = g_conv[ch + e]; }
                float ua[8] = {0.f, 0.f, 0.f, 0.f, 0.f, 0.f, 0.f, 0.f}, ub[8] = {0.f, 0.f, 0.f, 0.f, 0.f, 0.f, 0.f, 0.f}, uc[8];
                for (int tt = -2; tt < tpw; ++tt) {
                    const int t = tpw * wave + tt;
                    const int tg = isA ? 64 * c + t : t;
                    if (tg >= 0) { const bf16* pr = PROJ + (isA ? (size_t)b * SEQ + tg : (size_t)NPROMPT + 32 * b + tg) * NIN;
                        const v4u cw = *(const v4u*)(pr + COL_C + ch), uw = *(const v4u*)(pr + COL_U + ch);
                        uc[0] = bflo(cw.x) * bflo(uw.x); uc[1] = bfhi(cw.x) * bfhi(uw.x); uc[2] = bflo(cw.y) * bflo(uw.y); uc[3] = bfhi(cw.y) * bfhi(uw.y);
                        uc[4] = bflo(cw.z) * bflo(uw.z); uc[5] = bfhi(cw.z) * bfhi(uw.z); uc[6] = bflo(cw.w) * bflo(uw.w); uc[7] = bfhi(cw.w) * bfhi(uw.w); }
                    else if (isA) { const float* mp = METAPROJ + (size_t)(16 + tg) * NIN;
#pragma unroll
                        for (int e = 0; e < 8; ++e) uc[e] = mp[COL_C + ch + e] * mp[COL_U + ch + e]; }
                    else { const float* sp = state_conv + ((size_t)b * 2 + (2 + tg)) * CONVD + ch;
#pragma unroll
                        for (int e = 0; e < 8; ++e) uc[e] = sp[e]; }
                    if (tt >= 0) {
                        const size_t row = row0 + t; const v4u bw = *(const v4u*)(PROJ + row * NIN + COL_B + ch);
                        float bv[8] = {bflo(bw.x), bfhi(bw.x), bflo(bw.y), bfhi(bw.y), bflo(bw.z), bfhi(bw.z), bflo(bw.w), bfhi(bw.w)};
                        float y[8]; float ss = 0.f;
#pragma unroll
                        for (int e = 0; e < 8; ++e) { y[e] = bv[e] * (w0[e] * ua[e] + w1[e] * ub[e] + w2[e] * uc[e]); ss += y[e] * y[e]; }
                        const float rstd = 1.0f / sqrtf(wave_sum(ss) * (1.f / CONVD) + EPS);
                        v4u w; w.x = pk2(y[0] * rstd * gc[0], y[1] * rstd * gc[1]); w.y = pk2(y[2] * rstd * gc[2], y[3] * rstd * gc[3]); w.z = pk2(y[4] * rstd * gc[4], y[5] * rstd * gc[5]); w.w = pk2(y[6] * rstd * gc[6], y[7] * rstd * gc[7]);
                        *(v4u*)(MIX + row * D + ch) = w;
                        const int last = isA ? (c == SEQ / 64 - 1 ? 64 : 1 << 30) : 32;
                        if (t >= last - 2) { float* dst = (isA ? out + O_PC + ((size_t)b * 2 + (t - (last - 2))) * CONVD : out + O_SC + ((size_t)b * 2 + (t - (last - 2))) * CONVD) + ch;
#pragma unroll
                            for (int e = 0; e < 8; ++e) dst[e] = uc[e]; }
                    }
#pragma unroll
                    for (int e = 0; e < 8; ++e) { ua[e] = ub[e]; ub[e] = uc[e]; }
                }
            }
            __syncthreads();
        }
    }
    grid.sync();

    {
        pg8::Gemm g{MIX, WoutT, MTOT, D, D}; pg8::StaticOrder S; S.init(MTOT, D, G, bid);
        pg8::EpiOut E{x_prompt, x_sample, out, XN2, SSQ, NPROMPT};
        pg8::gemm_phase<pg8::EpiOut, pg8::StaticOrder, true, true>(lds, g, S, E);
    }
    grid.sync();

    {
        pg8::Gemm g{XN2, WupT, MTOT, FF, D}; pg8::StaticOrder S; S.init(MTOT, FF, G, bid);
        pg8::EpiUp E{HID, FF, SSQ};
        pg8::gemm_phase<pg8::EpiUp, pg8::StaticOrder, true, true>(lds, g, S, E);
    }
    grid.sync();

    {
        pg8::Gemm g{HID, WdnT, MTOT, D, FF}; pg8::StaticOrder S; S.init(MTOT, D, G, bid);
        pg8::EpiDown E{out};
        pg8::gemm_phase<pg8::EpiDown, pg8::StaticOrder, true, true>(lds, g, S, E);
    }
    grid.sync();

    {
        const int gw = bid * NWAVES + wave, NGW = G * NWAVES;
        for (int m = gw; m < MTOT; m += NGW) {
            f32x4* xr = (f32x4*)(out + (size_t)m * D) + lane; const f32x4* gr = (const f32x4*)g_final + lane;
            f32x4 v[4]; float s = 0.f;
#pragma unroll
            for (int j = 0; j < 4; ++j) { v[j] = xr[64 * j]; s += (v[j].x * v[j].x + v[j].y * v[j].y) + (v[j].z * v[j].z + v[j].w * v[j].w); }
            const float rstd = 1.0f / sqrtf(wave_sum(s) * (1.f / D) + EPS);
#pragma unroll
            for (int j = 0; j < 4; ++j) { const f32x4 gg = gr[64 * j]; xr[64 * j] = v[j] * rstd * gg; }
        }
    }
}

extern "C" void kernel_launch(void* const* d_in, const int* in_sizes, int n_in, void* d_out, int out_size, void* d_ws, size_t ws_size, hipStream_t stream) {
    static int grid = 0;
    if (grid == 0) {
        if (n_in != 20 || in_sizes[0] != NPROMPT * D || out_size != (int)O_END || ws_size < WS_END) { fprintf(stderr, "kernel_launch: unexpected shapes (n_in %d, in0 %d, out %d, ws %zu)\n", n_in, n_in > 0 ? in_sizes[0] : -1, out_size, ws_size); grid = -1; return; }
        int dev = 0, cus = 0, per_cu = 0;
        if (hipGetDevice(&dev) != hipSuccess || hipDeviceGetAttribute(&cus, hipDeviceAttributeMultiprocessorCount, dev) != hipSuccess) { grid = -1; return; }
        if (hipFuncSetAttribute((const void*)fwd_kernel, hipFuncAttributeMaxDynamicSharedMemorySize, LDS_BYTES) != hipSuccess) { fprintf(stderr, "kernel_launch: hipFuncSetAttribute failed\n"); grid = -1; return; }
        if (hipOccupancyMaxActiveBlocksPerMultiprocessor(&per_cu, (const void*)fwd_kernel, NTHREADS, LDS_BYTES) != hipSuccess || per_cu < 1) { fprintf(stderr, "kernel_launch: occupancy query says %d blocks per CU\n", per_cu); (void)hipGetLastError(); grid = -1; return; }
        grid = cus;
    }
    if (grid < 0) return;
    Params p{};
    for (int i = 0; i < 20; ++i) p.in[i] = (const float*)d_in[i];
    p.out = (float*)d_out; p.ws = (unsigned char*)d_ws;
    void* args[] = {&p};
    hipError_t e = hipLaunchCooperativeKernel((const void*)fwd_kernel, dim3(grid), dim3(NTHREADS), args, LDS_BYTES, stream);
    if (e != hipSuccess) fprintf(stderr, "kernel_launch: cooperative launch failed: %s (grid %d)\n", hipGetErrorString(e), grid);
}
```

```cpp
#include <hip/hip_runtime.h>
#include <hip/hip_cooperative_groups.h>
#include <cstdio>
#include <cstdint>
namespace cg = cooperative_groups;
namespace pg8 {
#define PG8_LAS __attribute__((address_space(3)))
typedef unsigned short bf16_t;
typedef short bf16x8 __attribute__((ext_vector_type(8)));
typedef float f32x4 __attribute__((ext_vector_type(4)));
typedef unsigned u32x4 __attribute__((ext_vector_type(4)));
constexpr int BM = 256, BK = 64, HALF = 128, HTB = HALF * BK * 2  , STAGE_BYTES = 8 * HTB, NXCD = 8, WGM = 8;

__host__ __device__ __forceinline__ int lds_byte(int r, int c) { const int st = (r >> 4) * 2 + (c >> 5), rr = r & 15, cc = c & 31, ob = rr * 64 + cc * 2; return st * 1024 + (ob ^ (((ob >> 9) & 1) << 5)); }
__host__ __device__ __forceinline__ void stage_rc(int b, int& R, int& C) { const int st = b / 1024, sb = b % 1024, swz = sb ^ (((sb >> 9) & 1) << 5); R = (st >> 1) * 16 + swz / 64; C = (st & 1) * 32 + (swz % 64) / 2; }
__host__ __device__ __forceinline__ int perm32(int rho) { const int n = rho >> 4, i = rho & 15; return 8 * (i >> 2) + 4 * n + (i & 3); }

struct Unit { int pm, pn; };
struct Gemm { const bf16_t* A; const bf16_t* Bt; int M, N, K; };

struct StaticOrder {
    int nM, nN, nwg, G, c;
    __host__ __device__ void init(int M, int N, int G_, int c_) { nM = M / BM; nN = N / BM; nwg = nM * nN; G = G_; c = c_; }
    __host__ __device__ bool next(int i, Unit& u) const {
        const long L = (long)i * G + c; if (L >= nwg) return false;
        int wgid = (int)L; { const int q = nwg / NXCD, r = nwg % NXCD, xcd = wgid % NXCD, off = wgid / NXCD; wgid = (xcd < r ? xcd * (q + 1) : r * (q + 1) + (xcd - r) * q) + off; }
        const int nig = WGM * nN, gid = wgid / nig, fm = gid * WGM, gsz = (nM - fm) < WGM ? (nM - fm) : WGM;
        u.pm = fm + ((wgid % nig) % gsz); u.pn = (wgid % nig) / gsz; return true;
    }
    __device__ __forceinline__ void a_ready(const Unit&) const {}
    __device__ __forceinline__ void done(const Unit&) const {}
};

__device__ __forceinline__ unsigned cvt_pk_bf16(float lo, float hi) { unsigned r; asm volatile("v_cvt_pk_bf16_f32 %0, %1, %2" : "=v"(r) : "v"(lo), "v"(hi)); return r; }
typedef unsigned u32x2 __attribute__((ext_vector_type(2)));
constexpr float RMS_EPS = 1e-6f;

struct EpiProj {
    static constexpr bool PERM = true, AFTER_DRAIN = false;
    bf16_t* O; int ldc;
    __device__ __forceinline__ void operator()(const f32x4 (&acc)[2][2][4][2], const Unit& u, int wr, int wc, int fr, int fq) const {
        const int row0 = u.pm * BM + wr * 64 + fr, col0 = u.pn * BM + wc * 32 + 8 * fq;
#pragma unroll
        for (int ai = 0; ai < 2; ++ai)
#pragma unroll
            for (int m = 0; m < 4; ++m) { bf16_t* rowp = O + (size_t)(row0 + ai * HALF + m * 16) * ldc + col0;
#pragma unroll
                for (int bj = 0; bj < 2; ++bj) { const f32x4 v0 = acc[ai][bj][m][0], v1 = acc[ai][bj][m][1];
                    u32x4 w; w.x = cvt_pk_bf16(v0[0], v0[1]); w.y = cvt_pk_bf16(v0[2], v0[3]); w.z = cvt_pk_bf16(v1[0], v1[1]); w.w = cvt_pk_bf16(v1[2], v1[3]);
                    *(u32x4*)(rowp + bj * HALF) = w; } }
    }
};
struct EpiUp {
    static constexpr bool PERM = true, AFTER_DRAIN = false;
    bf16_t* O; int ldc; const float* ssq;
    __device__ __forceinline__ void operator()(const f32x4 (&acc)[2][2][4][2], const Unit& u, int wr, int wc, int fr, int fq) const {
        const int row0 = u.pm * BM + wr * 64 + fr, col0 = u.pn * BM + wc * 32 + 8 * fq;
#pragma unroll
        for (int ai = 0; ai < 2; ++ai)
#pragma unroll
            for (int m = 0; m < 4; ++m) { const int row = row0 + ai * HALF + m * 16; bf16_t* rowp = O + (size_t)row * ldc + col0;
                const f32x4* sp = (const f32x4*)(ssq + (size_t)row * 16); const f32x4 s0 = sp[0], s1 = sp[1], s2 = sp[2], s3 = sp[3];
                const float tot = ((s0[0] + s0[1]) + (s0[2] + s0[3])) + ((s1[0] + s1[1]) + (s1[2] + s1[3])) + ((s2[0] + s2[1]) + (s2[2] + s2[3])) + ((s3[0] + s3[1]) + (s3[2] + s3[3]));
                const float rs = 1.0f / sqrtf(tot * (1.0f / 1024.0f) + RMS_EPS);
#pragma unroll
                for (int bj = 0; bj < 2; ++bj) { f32x4 v0 = acc[ai][bj][m][0] * rs, v1 = acc[ai][bj][m][1] * rs;
#pragma unroll
                    for (int e = 0; e < 4; ++e) { v0[e] = fmaxf(v0[e], 0.f); v0[e] *= v0[e]; v1[e] = fmaxf(v1[e], 0.f); v1[e] *= v1[e]; }
                    u32x4 w; w.x = cvt_pk_bf16(v0[0], v0[1]); w.y = cvt_pk_bf16(v0[2], v0[3]); w.z = cvt_pk_bf16(v1[0], v1[1]); w.w = cvt_pk_bf16(v1[2], v1[3]);
                    *(u32x4*)(rowp + bj * HALF) = w; } }
    }
};
struct EpiOut {
    static constexpr bool PERM = false, AFTER_DRAIN = false;
    const float* xp; const float* xs; float* out; bf16_t* xn; float* ssq; int nprompt;
    __device__ __forceinline__ void operator()(const f32x4 (&acc)[2][2][4][2], const Unit& u, int wr, int wc, int fr, int fq) const {
        const int col0 = u.pn * BM + wc * 32 + 4 * fq;
#pragma unroll
        for (int ai = 0; ai < 2; ++ai)
#pragma unroll
            for (int m = 0; m < 4; ++m) { const int row = u.pm * BM + ai * HALF + wr * 64 + m * 16 + fr;
                const float* base = (row < nprompt) ? xp + (size_t)row * 1024 : xs + (size_t)(row - nprompt) * 1024;
                float q = 0.f;
#pragma unroll
                for (int bj = 0; bj < 2; ++bj)
#pragma unroll
                    for (int n = 0; n < 2; ++n) { const int c = col0 + bj * HALF + n * 16; const f32x4 h = *(const f32x4*)(base + c) + acc[ai][bj][m][n];
                        *(f32x4*)(out + (size_t)row * 1024 + c) = h; u32x2 w; w.x = cvt_pk_bf16(h[0], h[1]); w.y = cvt_pk_bf16(h[2], h[3]); *(u32x2*)(xn + (size_t)row * 1024 + c) = w;
                        q += (h[0] * h[0] + h[1] * h[1]) + (h[2] * h[2] + h[3] * h[3]); }
                q += __shfl_xor(q, 16); q += __shfl_xor(q, 32);
                if (fq == 0) ssq[(size_t)row * 16 + u.pn * 4 + wc] = q; }
    }
};
struct EpiDown {
    static constexpr bool PERM = false, AFTER_DRAIN = false;
    float* out;
    __device__ __forceinline__ void operator()(const f32x4 (&acc)[2][2][4][2], const Unit& u, int wr, int wc, int fr, int fq) const {
        const int col0 = u.pn * BM + wc * 32 + 4 * fq;
#pragma unroll
        for (int ai = 0; ai < 2; ++ai)
#pragma unroll
            for (int m = 0; m < 4; ++m) { const int row = u.pm * BM + ai * HALF + wr * 64 + m * 16 + fr; float* rowp = out + (size_t)row * 1024 + col0;
#pragma unroll
                for (int bj = 0; bj < 2; ++bj)
#pragma unroll
                    for (int n = 0; n < 2; ++n) { float* p = rowp + bj * HALF + n * 16; *(f32x4*)p = *(const f32x4*)p + acc[ai][bj][m][n]; } }
    }
};

template <class Epi, class Sched, bool ALIGN_EPI = false, bool SP2 = false>
__device__ __forceinline__ void gemm_phase(PG8_LAS unsigned char* lds, const Gemm g, const Sched& S, const Epi& E) {
    int tid_l = threadIdx.x; asm volatile("" : "+v"(tid_l));
    const int tid = tid_l, wid = __builtin_amdgcn_readfirstlane(tid >> 6), lane = tid & 63, wr = wid >> 2, wc = wid & 3, fr = lane & 15, fq = lane >> 4;
    const int K = g.K, nt = K / BK;
    unsigned voffA[2], voffB[2];
#pragma unroll
    for (int i = 0; i < 2; ++i) { int R, C; stage_rc(tid * 16 + i * 8192, R, C); const int Rb = Epi::PERM ? ((R & ~31) + perm32(R & 31)) : R;
        voffA[i] = (unsigned)(R * K + C) * 2u; voffB[i] = (unsigned)(Rb * K + C) * 2u; }
    const size_t kstep = (size_t)(BK * 2);
    const size_t hstep = (size_t)HALF * K * 2;
    const size_t tstep = 2 * hstep;
    const unsigned ldsw = (unsigned)wid * 1024u;
    const int aoff = lds_byte(wr * 64 + fr, fq * 8), boff = lds_byte(wc * 32 + fr, fq * 8);
#define PG8_SA(b, h) (((b) * 2 + (h)) * HTB)
#define PG8_SB(b, h) ((4 + (b) * 2 + (h)) * HTB)
#define PG8_STAGE(bufoff, gbase, voff) do { _Pragma("unroll") for (int _i = 0; _i < 2; ++_i) \
        __builtin_amdgcn_global_load_lds((const unsigned*)((const char*)(gbase) + (voff)[_i]), (PG8_LAS unsigned*)(lds + (bufoff) + ldsw + _i * 8192), 16, 0, 0); } while (0)
#define PG8_LDA(dst, b, h) do { _Pragma("unroll") for (int m = 0; m < 4; ++m) _Pragma("unroll") for (int k = 0; k < 2; ++k) dst[m][k] = *(const PG8_LAS bf16x8*)(lds + PG8_SA(b, h) + aoff + m * 2048 + k * 1024); } while (0)
#define PG8_LDB(dst, b, h) do { _Pragma("unroll") for (int n = 0; n < 2; ++n) _Pragma("unroll") for (int k = 0; k < 2; ++k) dst[n][k] = *(const PG8_LAS bf16x8*)(lds + PG8_SB(b, h) + boff + n * 2048 + k * 1024); } while (0)
#define PG8_MMA(ai, bj, At, Bt) do { __builtin_amdgcn_s_setprio(1); _Pragma("unroll") for (int m = 0; m < 4; ++m) _Pragma("unroll") for (int n = 0; n < 2; ++n) _Pragma("unroll") for (int k = 0; k < 2; ++k) \
        acc[ai][bj][m][n] = __builtin_amdgcn_mfma_f32_16x16x32_bf16(Bt[n][k], At[m][k], acc[ai][bj][m][n], 0, 0, 0); __builtin_amdgcn_s_setprio(0); } while (0)
#define PG8_WAIT_V(n) asm volatile("s_waitcnt vmcnt(" #n ")" ::: "memory")
#define PG8_WAIT_L(n) asm volatile("s_waitcnt lgkmcnt(" #n ")" ::: "memory")
#define PG8_BAR __builtin_amdgcn_s_barrier()
#define PG8_SCHED __builtin_amdgcn_sched_barrier(0)
    Unit cur, nxt; int ui = 0;
    if (!S.next(0, cur)) return;
    f32x4 acc[2][2][4][2];
#pragma unroll
    for (int a = 0; a < 2; ++a)
#pragma unroll
        for (int b = 0; b < 2; ++b)
#pragma unroll
            for (int m = 0; m < 4; ++m)
#pragma unroll
                for (int n = 0; n < 2; ++n) acc[a][b][m][n] = (f32x4){0.f, 0.f, 0.f, 0.f};
    bf16x8 At[4][2], B0[2][2], B1[2][2];
    const char* cA = (const char*)g.A + (size_t)cur.pm * tstep; const char* cB = (const char*)g.Bt + (size_t)cur.pn * tstep;
    S.a_ready(cur);
    if constexpr (SP2) {
        PG8_STAGE(PG8_SB(0, 0), cB, voffB); PG8_STAGE(PG8_SB(0, 1), cB + hstep, voffB); PG8_STAGE(PG8_SA(0, 0), cA, voffA); PG8_STAGE(PG8_SA(0, 1), cA + hstep, voffA);
        if (wr == 1) PG8_BAR;
        PG8_WAIT_V(2); PG8_BAR;
        PG8_STAGE(PG8_SB(1, 0), cB + kstep, voffB); PG8_STAGE(PG8_SA(1, 0), cA + kstep, voffA); PG8_STAGE(PG8_SB(1, 1), cB + hstep + kstep, voffB);
        PG8_WAIT_V(6); PG8_BAR;
    } else {
        PG8_STAGE(PG8_SB(0, 0), cB, voffB); PG8_STAGE(PG8_SA(0, 0), cA, voffA); PG8_STAGE(PG8_SB(0, 1), cB + hstep, voffB); PG8_STAGE(PG8_SA(0, 1), cA + hstep, voffA);
        if (wr == 1) PG8_BAR;
        PG8_WAIT_V(4); PG8_BAR;
        PG8_STAGE(PG8_SB(1, 0), cB + kstep, voffB); PG8_STAGE(PG8_SA(1, 0), cA + kstep, voffA); PG8_STAGE(PG8_SB(1, 1), cB + hstep + kstep, voffB);
        PG8_WAIT_V(6); PG8_BAR;
    }
    for (;;) {
        const bool has_next = S.next(ui + 1, nxt);
        const char* nA = has_next ? (const char*)g.A + (size_t)nxt.pm * tstep : cA; const char* nB = has_next ? (const char*)g.Bt + (size_t)nxt.pn * tstep : cB;
        for (int t = 0; t < nt; t += 2) {
            const bool last = (t == nt - 2);
            const char* a1 = cA + (size_t)(t + 1) * kstep;
            const char* a2 = last ? nA : cA + (size_t)(t + 2) * kstep; const char* b2 = last ? nB : cB + (size_t)(t + 2) * kstep;
            const char* a3 = a2 + kstep; const char* b3 = b2 + kstep;
            if (last && has_next) S.a_ready(nxt);
            if constexpr (SP2) {
            PG8_LDB(B0, 0, 0); PG8_LDB(B1, 0, 1); PG8_SCHED; PG8_LDA(At, 0, 0); PG8_STAGE(PG8_SA(1, 1), a1 + hstep, voffA);
            PG8_WAIT_V(8); PG8_WAIT_L(0); PG8_BAR; PG8_MMA(0, 0, At, B0); PG8_MMA(0, 1, At, B1); PG8_BAR; PG8_SCHED;
            PG8_LDA(At, 0, 1); PG8_STAGE(PG8_SB(0, 0), b2, voffB); PG8_STAGE(PG8_SB(0, 1), b2 + hstep, voffB); PG8_STAGE(PG8_SA(0, 0), a2, voffA);
            PG8_WAIT_V(8); PG8_WAIT_L(0); PG8_BAR; PG8_MMA(1, 0, At, B0); PG8_MMA(1, 1, At, B1); PG8_BAR; PG8_SCHED;
            PG8_LDB(B0, 1, 0); PG8_LDB(B1, 1, 1); PG8_SCHED; PG8_LDA(At, 1, 0); PG8_STAGE(PG8_SA(0, 1), a2 + hstep, voffA);
            PG8_WAIT_V(8); PG8_WAIT_L(0); PG8_BAR; PG8_MMA(0, 0, At, B0); PG8_MMA(0, 1, At, B1); PG8_BAR; PG8_SCHED;
            PG8_LDA(At, 1, 1); PG8_STAGE(PG8_SB(1, 0), b3, voffB); PG8_STAGE(PG8_SB(1, 1), b3 + hstep, voffB); PG8_STAGE(PG8_SA(1, 0), a3, voffA);
            PG8_WAIT_V(8); PG8_WAIT_L(0); PG8_BAR; PG8_MMA(1, 0, At, B0); PG8_MMA(1, 1, At, B1); PG8_BAR; PG8_SCHED;
            } else {
            PG8_LDB(B0, 0, 0); PG8_SCHED; PG8_LDA(At, 0, 0); PG8_STAGE(PG8_SA(1, 1), a1 + hstep, voffA);
            PG8_WAIT_L(8); PG8_BAR; PG8_WAIT_L(0); PG8_MMA(0, 0, At, B0); PG8_BAR; PG8_SCHED;
            PG8_LDB(B1, 0, 1); PG8_STAGE(PG8_SB(0, 0), b2, voffB);
            PG8_BAR; PG8_WAIT_L(0); PG8_MMA(0, 1, At, B1); PG8_BAR;
            PG8_LDA(At, 0, 1); PG8_STAGE(PG8_SA(0, 0), a2, voffA);
            PG8_BAR; PG8_WAIT_L(0); PG8_MMA(1, 0, At, B0); PG8_BAR; PG8_SCHED;
            PG8_STAGE(PG8_SB(0, 1), b2 + hstep, voffB);
            PG8_WAIT_V(6); PG8_BAR; PG8_MMA(1, 1, At, B1); PG8_BAR;
            PG8_LDB(B0, 1, 0); PG8_SCHED; PG8_LDA(At, 1, 0); PG8_STAGE(PG8_SA(0, 1), a2 + hstep, voffA);
            PG8_WAIT_L(8); PG8_BAR; PG8_WAIT_L(0); PG8_MMA(0, 0, At, B0); PG8_BAR; PG8_SCHED;
            PG8_LDB(B1, 1, 1); PG8_STAGE(PG8_SB(1, 0), b3, voffB);
            PG8_BAR; PG8_WAIT_L(0); PG8_MMA(0, 1, At, B1); PG8_BAR;
            PG8_LDA(At, 1, 1); PG8_STAGE(PG8_SA(1, 0), a3, voffA);
            PG8_BAR; PG8_WAIT_L(0); PG8_MMA(1, 0, At, B0); PG8_BAR; PG8_SCHED;
            PG8_STAGE(PG8_SB(1, 1), b3 + hstep, voffB);
            PG8_WAIT_V(6); PG8_BAR; PG8_MMA(1, 1, At, B1); PG8_BAR;
            }
        }
        if constexpr (ALIGN_EPI) { if (wr == 0) PG8_BAR; }
        if constexpr (!Epi::AFTER_DRAIN) { E(acc, cur, wr, wc, fr, fq); S.done(cur); }
        if (!has_next) break;
#pragma unroll
        for (int a = 0; a < 2; ++a)
#pragma unroll
            for (int b = 0; b < 2; ++b)
#pragma unroll
                for (int m = 0; m < 4; ++m)
#pragma unroll
                    for (int n = 0; n < 2; ++n) acc[a][b][m][n] = (f32x4){0.f, 0.f, 0.f, 0.f};
        cur = nxt; cA = nA; cB = nB; ++ui;
        if constexpr (ALIGN_EPI) { if (wr == 1) PG8_BAR; }
    }
    PG8_WAIT_V(0);
    if constexpr (!ALIGN_EPI) { if (wr == 0) PG8_BAR; }
    PG8_BAR;
    if constexpr (Epi::AFTER_DRAIN) { E.fused(acc, cur, wr, wc, fr, fq, lds, wid, lane); S.done(cur); }
#undef PG8_SA
#undef PG8_SB
#undef PG8_STAGE
#undef PG8_LDA
#undef PG8_LDB
#undef PG8_MMA
#undef PG8_WAIT_V
#undef PG8_WAIT_L
#undef PG8_BAR
#undef PG8_SCHED
}
}

constexpr int D = 1024, NIN = 2304, FF = 4096;
constexpr int NB = 8, SEQ = 8192, NPROMPT = NB * SEQ;
constexpr int SB = 16, SS = 32, NSAMP = SB * SS;
constexpr int MTOT = NPROMPT + NSAMP;
constexpr int NMETA = 16, CONVD = 512, QD = 512, KVD = 128, HD = 64;
constexpr int COL_B = 0, COL_C = 512, COL_U = 1024, COL_Q = 1536, COL_K = 2048, COL_V = 2176;
constexpr float EPS = 1e-6f;
constexpr float LOG2E = 1.4426950408889634f;
constexpr float C2 = 0.125f * LOG2E;
constexpr size_t O_YP = 0, O_YS = 67108864, O_PK = 67633152, O_PV = 67764224, O_PMK = 67895296, O_PMV = 67911680, O_PC = 67928064, O_SK = 67936256, O_SV = 68001792, O_SC = 68067328, O_END = 68083712;
constexpr size_t MiB = 1u << 20;
constexpr size_t WS_WIN = 2 * MiB, WS_WOUT = 8 * MiB, WS_WUP = 10 * MiB, WS_WDN = 18 * MiB;
constexpr size_t WS_METAPROJ = 26 * MiB;
constexpr size_t WS_METAKV = 26 * MiB + 256 * 1024;
constexpr size_t WS_SSQ = 27 * MiB;
constexpr size_t WS_XN2 = 32 * MiB;
constexpr size_t WS_XN0 = 161 * MiB;
constexpr size_t WS_PROJ = 290 * MiB;
constexpr size_t WS_MIX = 581 * MiB;
constexpr size_t WS_HID = 161 * MiB;
constexpr size_t WS_END = 710 * MiB;
static_assert(WS_SSQ + (size_t)MTOT * 16 * 4 <= WS_XN2 && WS_XN2 + (size_t)MTOT * D * 2 <= WS_XN0 && WS_XN0 + (size_t)MTOT * D * 2 <= WS_PROJ && WS_PROJ + (size_t)MTOT * NIN * 2 <= WS_MIX && WS_MIX + (size_t)MTOT * D * 2 <= WS_END && WS_HID + (size_t)MTOT * FF * 2 <= WS_END, "ws map");

constexpr int NWAVES = 8, NTHREADS = 512;
constexpr int LDS_BYTES = 147456;

#define LAS __attribute__((address_space(3)))
typedef unsigned short bf16;
typedef unsigned v4u __attribute__((ext_vector_type(4)));
typedef float f32x4 __attribute__((ext_vector_type(4)));

__device__ __forceinline__ unsigned f2bf(float f) { unsigned u = __builtin_bit_cast(unsigned, f); return (u + 0x7fffu + ((u >> 16) & 1u)) >> 16; }
__device__ __forceinline__ unsigned pk2(float lo, float hi) { return f2bf(lo) | (f2bf(hi) << 16); }
__device__ __forceinline__ float bflo(unsigned w) { return __builtin_bit_cast(float, w << 16); }
__device__ __forceinline__ float bfhi(unsigned w) { return __builtin_bit_cast(float, w & 0xffff0000u); }
__device__ __forceinline__ float wave_sum(float v) {
#pragma unroll
    for (int o = 1; o < 64; o <<= 1) v += __shfl_xor(v, o);
    return v;
}

struct Params {
    const float* in[20];
    float* out;
    unsigned char* ws;
};

__device__ __forceinline__ void p0_transpose_item(const float* W, int K, int N, bf16* WT, const float* gk, LAS float* scr, int item, int lane) {
    const int nblk = N / 32, kb = item / nblk, nb = item % nblk, k0 = 64 * kb, n0 = 32 * nb;
#pragma unroll 8
    for (int i = 0; i < 32; ++i) { const int kk = 2 * i + (lane >> 5); float v = W[(size_t)(k0 + kk) * N + n0 + (lane & 31)]; if (gk) v *= gk[k0 + kk]; scr[kk * 33 + (lane & 31)] = v; }
    asm volatile("s_waitcnt lgkmcnt(0)" ::: "memory");
    const int c = lane & 7;
#pragma unroll
    for (int j = 0; j < 4; ++j) { const int n = (lane >> 3) + 8 * j; const LAS float* s = scr + (8 * c) * 33 + n;
        v4u o; o.x = pk2(s[0 * 33], s[1 * 33]); o.y = pk2(s[2 * 33], s[3 * 33]); o.z = pk2(s[4 * 33], s[5 * 33]); o.w = pk2(s[6 * 33], s[7 * 33]);
        *(v4u*)(WT + (size_t)(n0 + n) * K + k0 + 8 * c) = o; }
    asm volatile("s_waitcnt lgkmcnt(0)" ::: "memory");
}
__device__ __forceinline__ void rms_row_to_bf16(const float* xrow, const float* g, bf16* orow, int lane) {
    const f32x4* xr = (const f32x4*)xrow + lane; const f32x4* gr = (const f32x4*)g + lane;
    f32x4 v[4]; float s = 0.f;
#pragma unroll
    for (int j = 0; j < 4; ++j) { v[j] = xr[64 * j]; s += (v[j].x * v[j].x + v[j].y * v[j].y) + (v[j].z * v[j].z + v[j].w * v[j].w); }
    const float rstd = 1.0f / sqrtf(wave_sum(s) * (1.f / D) + EPS);
    unsigned long long* o8 = (unsigned long long*)orow + lane;
#pragma unroll
    for (int j = 0; j < 4; ++j) { const f32x4 gg = gr[64 * j];
        o8[64 * j] = (unsigned long long)pk2(v[j].x * rstd * gg.x, v[j].y * rstd * gg.y) | ((unsigned long long)pk2(v[j].z * rstd * gg.z, v[j].w * rstd * gg.w) << 32); }
}

__device__ __forceinline__ int t5_bucket(int rel) {
    const int n = rel < 0 ? -rel : rel; int ret = rel > 0 ? 16 : 0;
    if (n < 8) return ret + n;
    int large = (31 - __clz(n * n)) + 2; if (large > 15) large = 15;
    return ret + large;
}


typedef float f32x16 __attribute__((ext_vector_type(16)));
typedef short bf16x8v __attribute__((ext_vector_type(8)));
typedef short v4i16_t __attribute__((ext_vector_type(4)));
template <int NQT>
__device__ __forceinline__ void attn_core(LAS unsigned char* KIMG, LAS unsigned char* VIMG, const LAS float* BREL, LAS float* SSQX, const bf16* PROJ, bf16* MIX, const float* g_attn, const float* sinks,
                                          size_t row0, int kt0, int ntiles, int metaoff, int wave, int lane) {
    asm volatile("" : "+v"(lane));
    const int h = wave, kvh = h >> 2, q = lane & 31, hh = lane >> 5;
    bf16x8v qf[NQT][4];
#pragma unroll
    for (int qt = 0; qt < NQT; ++qt)
#pragma unroll
        for (int ks = 0; ks < 4; ++ks) qf[qt][ks] = *(const bf16x8v*)(PROJ + (row0 + 32 * qt + q) * NIN + COL_Q + 64 * h + 16 * ks + 8 * hh);
    f32x16 O[NQT][2]; float m[NQT], l[NQT];
    const float sink2 = sinks[h] * LOG2E;
#pragma unroll
    for (int qt = 0; qt < NQT; ++qt) { m[qt] = sink2; l[qt] = hh == 0 ? 1.f : 0.f;
#pragma unroll
        for (int dt = 0; dt < 2; ++dt)
#pragma unroll
            for (int r = 0; r < 16; ++r) O[qt][dt][r] = 0.f; }
    const int kswz = q & 15;
    int koff[4];
#pragma unroll
    for (int ks = 0; ks < 4; ++ks) koff[ks] = q * 256 + (((kvh * 8 + ks * 2 + hh) ^ kswz) << 4);
    const int G4 = lane >> 4, i16 = lane & 15, vsw = (i16 >> 2) & 3;
    int voff[2];
#pragma unroll
    for (int dt = 0; dt < 2; ++dt) voff[dt] = (4 * (G4 >> 1) + (i16 >> 2)) * 256 + ((((kvh * 2 + dt) ^ vsw) << 6) | ((G4 & 1) * 32 + (i16 & 3) * 8));
    for (int kt = kt0; kt < ntiles; ++kt) {
        bf16x8v kf[4], vf[2][2];
#pragma unroll
        for (int ks = 0; ks < 4; ++ks) kf[ks] = *(const LAS bf16x8v*)(KIMG + kt * 8192 + koff[ks]);
#pragma unroll
        for (int dt = 0; dt < 2; ++dt)
#pragma unroll
            for (int s = 0; s < 2; ++s) {
                const v4i16_t a = __builtin_amdgcn_ds_read_tr16_b64_v4i16((LAS v4i16_t*)(VIMG + kt * 8192 + s * 4096 + voff[dt]));
                const v4i16_t bq = __builtin_amdgcn_ds_read_tr16_b64_v4i16((LAS v4i16_t*)(VIMG + kt * 8192 + s * 4096 + 2048 + voff[dt]));
                vf[dt][s] = (bf16x8v){a[0], a[1], a[2], a[3], bq[0], bq[1], bq[2], bq[3]}; }
        const bool lastt = (kt == ntiles - 1);
#pragma unroll
        for (int qt = 0; qt < NQT; ++qt) {
            f32x16 S;
#pragma unroll
            for (int r = 0; r < 16; ++r) S[r] = 0.f;
#pragma unroll
            for (int ks = 0; ks < 4; ++ks) S = __builtin_amdgcn_mfma_f32_32x32x16_bf16(kf[ks], qf[qt][ks], S, 0, 0, 0);
            const int i = 32 * qt + q;
            float tmax;
            if (!lastt) {
                const LAS float* bp = BREL + h * 256 + (32 * kt + 63 + 4 * hh - i);
#pragma unroll
                for (int r = 0; r < 16; ++r) S[r] = S[r] * C2 + bp[(r & 3) + 8 * (r >> 2)];
                tmax = S[0];
#pragma unroll
                for (int r = 1; r < 16; ++r) tmax = fmaxf(tmax, S[r]);
            } else {
#pragma unroll
                for (int r = 0; r < 8; ++r) { const int kr = (r & 3) + 8 * (r >> 2) + 4 * hh; int rel = kr - metaoff - i; rel = rel < -191 ? -191 : rel; S[r] = S[r] * C2 + BREL[h * 256 + rel + 191]; }
                tmax = S[0];
#pragma unroll
                for (int r = 1; r < 8; ++r) tmax = fmaxf(tmax, S[r]);
#pragma unroll
                for (int r = 8; r < 16; ++r) S[r] = -INFINITY;
            }
            tmax = fmaxf(tmax, __shfl_xor(tmax, 32));
            const float mn = fmaxf(m[qt], tmax), sc = __builtin_amdgcn_exp2f(m[qt] - mn); m[qt] = mn;
            float psum = 0.f;
#pragma unroll
            for (int r = 0; r < 16; ++r) { S[r] = __builtin_amdgcn_exp2f(S[r] - mn); psum += S[r]; }
            l[qt] = l[qt] * sc + psum;
#pragma unroll
            for (int dt = 0; dt < 2; ++dt)
#pragma unroll
                for (int r = 0; r < 16; ++r) O[qt][dt][r] *= sc;
            bf16x8v pf[2];
#pragma unroll
            for (int s = 0; s < 2; ++s) { v4u w; w.x = pg8::cvt_pk_bf16(S[8 * s + 0], S[8 * s + 1]); w.y = pg8::cvt_pk_bf16(S[8 * s + 2], S[8 * s + 3]); w.z = pg8::cvt_pk_bf16(S[8 * s + 4], S[8 * s + 5]); w.w = pg8::cvt_pk_bf16(S[8 * s + 6], S[8 * s + 7]);
                pf[s] = __builtin_bit_cast(bf16x8v, w); }
#pragma unroll
            for (int dt = 0; dt < 2; ++dt)
#pragma unroll
                for (int s = 0; s < 2; ++s) O[qt][dt] = __builtin_amdgcn_mfma_f32_32x32x16_bf16(vf[dt][s], pf[s], O[qt][dt], 0, 0, 0);
        }
    }
#pragma unroll
    for (int qt = 0; qt < NQT; ++qt) {
        const float lt = l[qt] + __shfl_xor(l[qt], 32), inv = 1.0f / lt; float ss = 0.f;
#pragma unroll
        for (int dt = 0; dt < 2; ++dt)
#pragma unroll
            for (int r = 0; r < 16; ++r) { O[qt][dt][r] *= inv; ss += O[qt][dt][r] * O[qt][dt][r]; }
        ss += __shfl_xor(ss, 32);
        if (hh == 0) SSQX[h * 64 + 32 * qt + q] = ss;
    }
    __syncthreads();
#pragma unroll
    for (int qt = 0; qt < NQT; ++qt) {
        float tot = 0.f;
#pragma unroll
        for (int h2 = 0; h2 < 8; ++h2) tot += SSQX[h2 * 64 + 32 * qt + q];
        const float rstd = 1.0f / sqrtf(tot * (1.f / QD) + EPS);
        bf16* mrow = MIX + (row0 + 32 * qt + q) * D + CONVD + 64 * h;
#pragma unroll
        for (int dt = 0; dt < 2; ++dt)
#pragma unroll
            for (int g4 = 0; g4 < 4; ++g4) { const int d0 = 32 * dt + 8 * g4 + 4 * hh; const f32x4 gv = *(const f32x4*)(g_attn + 64 * h + d0);
                pg8::u32x2 w; w.x = pg8::cvt_pk_bf16(O[qt][dt][4 * g4 + 0] * rstd * gv.x, O[qt][dt][4 * g4 + 1] * rstd * gv.y); w.y = pg8::cvt_pk_bf16(O[qt][dt][4 * g4 + 2] * rstd * gv.z, O[qt][dt][4 * g4 + 3] * rstd * gv.w);
                *(pg8::u32x2*)(mrow + d0) = w; }
    }
}

__global__ void __launch_bounds__(NTHREADS, 2) fwd_kernel(Params p) {
    extern __shared__ __attribute__((aligned(16))) unsigned char lds_raw[];
    cg::grid_group grid = cg::this_grid();
    LAS unsigned char* lds = (LAS unsigned char*)lds_raw;
    const int tid = threadIdx.x, lane = tid & 63, wave = __builtin_amdgcn_readfirstlane(tid >> 6);
    const int G = gridDim.x, bid = blockIdx.x;
    unsigned char* ws = p.ws;
    const float* x_prompt = p.in[0]; const float* x_sample = p.in[1];
    const float* cache_k = p.in[2]; const float* cache_v = p.in[3]; const float* cache_mk = p.in[4]; const float* cache_mv = p.in[5];
    const float* state_conv = p.in[6]; const float* meta_tokens = p.in[7]; const float* g_mix = p.in[8]; const float* w_in = p.in[9];
    const float* conv_w = p.in[10]; const float* sinks = p.in[11]; const float* rel_table = p.in[12]; const float* g_conv = p.in[13];
    const float* g_attn = p.in[14]; const float* w_out = p.in[15]; const float* g_mlp = p.in[16]; const float* w_up = p.in[17];
    const float* w_down = p.in[18]; const float* g_final = p.in[19];
    float* out = p.out;
    bf16* WinT = (bf16*)(ws + WS_WIN); bf16* WoutT = (bf16*)(ws + WS_WOUT); bf16* WupT = (bf16*)(ws + WS_WUP); bf16* WdnT = (bf16*)(ws + WS_WDN);
    float* METAPROJ = (float*)(ws + WS_METAPROJ); bf16* METAKV = (bf16*)(ws + WS_METAKV); float* SSQ = (float*)(ws + WS_SSQ);
    bf16* XN0 = (bf16*)(ws + WS_XN0); bf16* PROJ = (bf16*)(ws + WS_PROJ); bf16* MIX = (bf16*)(ws + WS_MIX); bf16* XN2 = (bf16*)(ws + WS_XN2); bf16* HID = (bf16*)(ws + WS_HID);

    {
        if (bid < NIN / 64) {
            LAS float* xnT = (LAS float*)lds;
            LAS float* red = (LAS float*)(lds + 65536);
            for (int rr = 0; rr < 2; ++rr) { const int r = 2 * wave + rr; const f32x4* xr = (const f32x4*)(meta_tokens + (size_t)r * D) + lane; const f32x4* gr = (const f32x4*)g_mix + lane;
                f32x4 v[4]; float s = 0.f;
#pragma unroll
                for (int j = 0; j < 4; ++j) { v[j] = xr[64 * j]; s += (v[j].x * v[j].x + v[j].y * v[j].y) + (v[j].z * v[j].z + v[j].w * v[j].w); }
                const float rstd = 1.0f / sqrtf(wave_sum(s) * (1.f / D) + EPS);
#pragma unroll
                for (int j = 0; j < 4; ++j) { const f32x4 gg = gr[64 * j]; const int k = 4 * lane + 256 * j;
                    xnT[(k + 0) * 16 + r] = v[j].x * rstd * gg.x; xnT[(k + 1) * 16 + r] = v[j].y * rstd * gg.y; xnT[(k + 2) * 16 + r] = v[j].z * rstd * gg.z; xnT[(k + 3) * 16 + r] = v[j].w * rstd * gg.w; } }
            __syncthreads();
            const int n = 64 * bid + lane; float acc[16];
#pragma unroll
            for (int r = 0; r < 16; ++r) acc[r] = 0.f;
            for (int k = 128 * wave; k < 128 * wave + 128; ++k) { const float wv = w_in[(size_t)k * NIN + n]; const LAS f32x4* xs = (const LAS f32x4*)(xnT + k * 16);
#pragma unroll
                for (int q = 0; q < 4; ++q) { const f32x4 xv = xs[q]; acc[4 * q + 0] += xv.x * wv; acc[4 * q + 1] += xv.y * wv; acc[4 * q + 2] += xv.z * wv; acc[4 * q + 3] += xv.w * wv; } }
#pragma unroll
            for (int r = 0; r < 16; ++r) red[(wave * 16 + r) * 64 + lane] = acc[r];
            __syncthreads();
            for (int o = tid; o < 1024; o += NTHREADS) { const int r = o >> 6, l = o & 63; float s = 0.f;
#pragma unroll
                for (int w = 0; w < 8; ++w) s += red[(w * 16 + r) * 64 + l];
                const int nn = 64 * bid + l; METAPROJ[r * NIN + nn] = s;
                if (nn >= COL_K) { const int kc = nn - COL_K; METAKV[r * 256 + kc] = (bf16)f2bf(s);
                    float* dst = (kc < 128) ? out + O_PMK + r * 128 + kc : out + O_PMV + r * 128 + (kc - 128);
#pragma unroll
                    for (int b = 0; b < NB; ++b) dst[(size_t)b * NMETA * 128] = s; } }
            __syncthreads();
        }
        LAS float* scr = (LAS float*)(lds + wave * 16384);
        const int gw = bid * NWAVES + wave, NGW = G * NWAVES;
        constexpr int I_IN = (D / 64) * (NIN / 32), I_OUT = (D / 64) * (D / 32), I_UP = (D / 64) * (FF / 32), I_DN = (FF / 64) * (D / 32);
        constexpr int NITEMS = I_IN + I_OUT + I_UP + I_DN;
        for (int it = gw; it < NITEMS; it += NGW) {
            int r = it;
            if (r < I_IN) { p0_transpose_item(w_in, D, NIN, WinT, nullptr, scr, r, lane); continue; } r -= I_IN;
            if (r < I_OUT) { p0_transpose_item(w_out, D, D, WoutT, nullptr, scr, r, lane); continue; } r -= I_OUT;
            if (r < I_UP) { p0_transpose_item(w_up, D, FF, WupT, g_mlp, scr, r, lane); continue; } r -= I_UP;
            p0_transpose_item(w_down, FF, D, WdnT, nullptr, scr, r, lane);
        }
        for (int m = gw; m < MTOT; m += NGW) {
            const float* xrow = (m < NPROMPT) ? x_prompt + (size_t)m * D : x_sample + (size_t)(m - NPROMPT) * D;
            rms_row_to_bf16(xrow, g_mix, XN0 + (size_t)m * D, lane);
        }
    }
    grid.sync();

    {
        pg8::Gemm g{XN0, WinT, MTOT, NIN, D}; pg8::StaticOrder S; S.init(MTOT, NIN, G, bid);
        pg8::EpiProj E{PROJ, NIN};
        pg8::gemm_phase<pg8::EpiProj, pg8::StaticOrder, true, true>(lds, g, S, E);
    }
    grid.sync();

    {
        LAS unsigned char* KIMG = lds;
        LAS unsigned char* VIMG = lds + 57344;
        LAS float* BREL = (LAS float*)(lds + 114688);
        LAS float* SSQX = (LAS float*)(lds + 114688 + 8192);
        for (int o = tid; o < 8 * 256; o += NTHREADS) { const int h = o >> 8, idx = o & 255; const int rel = idx - 191; BREL[o] = (idx < 255) ? rel_table[t5_bucket(rel) * 8 + h] * LOG2E : 0.f; }
        __syncthreads();
        const int NUNITS = NB * (SEQ / 64) + SB;
        for (int u = bid; u < NUNITS; u += G) {
            const bool isA = u < NB * (SEQ / 64);
            const int b = isA ? u / (SEQ / 64) : u - NB * (SEQ / 64);
            const int c = isA ? u % (SEQ / 64) : 0;
            const int ntok = isA ? 64 : 32, nwin = isA ? 192 : 160, nk = nwin + 16, ntiles = isA ? 7 : 6;
            const size_t row0 = isA ? (size_t)b * SEQ + 64 * c : (size_t)NPROMPT + 32 * b;
            for (int ch = tid; ch < ntiles * 32 * 32; ch += NTHREADS) { const int j = ch >> 5, cc = ch & 31;
                v4u val = (v4u){0u, 0u, 0u, 0u};
                if (j < nk) {
                    if (isA) {
                        if (j < 192) { const int tk = 64 * (c - 2) + j; if (tk >= 0) val = *(const v4u*)(PROJ + ((size_t)b * SEQ + tk) * NIN + COL_K + 8 * cc); }
                        else val = *(const v4u*)(METAKV + (j - 192) * 256 + 8 * cc);
                    } else {
                        const float* src = nullptr;
                        if (j < 128) src = (cc < 16 ? cache_k : cache_v) + ((size_t)b * 128 + j) * 128 + 8 * (cc & 15);
                        else if (j >= 160) src = (cc < 16 ? cache_mk : cache_mv) + ((size_t)b * 16 + (j - 160)) * 128 + 8 * (cc & 15);
                        if (src) { const f32x4 a = *(const f32x4*)src, bb = *(const f32x4*)(src + 4); val.x = pk2(a.x, a.y); val.y = pk2(a.z, a.w); val.z = pk2(bb.x, bb.y); val.w = pk2(bb.z, bb.w); }
                        else val = *(const v4u*)(PROJ + (row0 + (j - 128)) * NIN + COL_K + 8 * cc);
                    }
                }
                if (cc < 16) *(LAS v4u*)(KIMG + j * 256 + ((cc ^ (j & 15)) << 4)) = val;
                else { const int c2 = cc - 16; *(LAS v4u*)(VIMG + j * 256 + (((((c2 >> 2) ^ (j & 3)) << 2) | (c2 & 3)) << 4)) = val; } }
            __syncthreads();
            if (isA) { if (c >= 126) { for (int o = tid; o < 64 * 256; o += NTHREADS) { const int i = o >> 8, col = o & 255; const float v = __builtin_bit_cast(float, (unsigned)PROJ[(row0 + i) * NIN + COL_K + col] << 16); const int t = 64 * (c - 126) + i;
                    if (col < 128) out[O_PK + ((size_t)b * 128 + t) * 128 + col] = v; else out[O_PV + ((size_t)b * 128 + t) * 128 + (col - 128)] = v; } } }
            else { for (int o = tid; o < 32 * 256; o += NTHREADS) { const int i = o >> 8, col = o & 255; const float v = __builtin_bit_cast(float, (unsigned)PROJ[(row0 + i) * NIN + COL_K + col] << 16);
                    if (col < 128) out[O_SK + ((size_t)b * 32 + i) * 128 + col] = v; else out[O_SV + ((size_t)b * 32 + i) * 128 + (col - 128)] = v; } }
            if (isA) attn_core<2>(KIMG, VIMG, BREL, SSQX, PROJ, MIX, g_attn, sinks, row0, (c >= 2 ? 0 : 4 - 2 * c), 7, 16 + 64 * c, wave, lane);
            else     attn_core<1>(KIMG, VIMG, BREL, SSQX, PROJ, MIX, g_attn, sinks, row0, 0, 6, 16 + 4096, wave, lane);
            {
                const int tpw = ntok / 8, ch = 8 * lane;
                float w0[8], w1[8], w2[8], gc[8];
#pragma unroll
                for (int e = 0; e < 8; ++e) { w0[e] = conv_w[ch + e]; w1[e] = conv_w[CONVD + ch + e]; w2[e] = conv_w[2 * CONVD + ch + e]; gc[e] = g_conv[ch + e]; }
                float ua[8] = {0.f, 0.f, 0.f, 0.f, 0.f, 0.f, 0.f, 0.f}, ub[8] = {0.f, 0.f, 0.f, 0.f, 0.f, 0.f, 0.f, 0.f}, uc[8];
                for (int tt = -2; tt < tpw; ++tt) {
                    const int t = tpw * wave + tt;
                    const int tg = isA ? 64 * c + t : t;
                    if (tg >= 0) { const bf16* pr = PROJ + (isA ? (size_t)b * SEQ + tg : (size_t)NPROMPT + 32 * b + tg) * NIN;
                        const v4u cw = *(const v4u*)(pr + COL_C + ch), uw = *(const v4u*)(pr + COL_U + ch);
                        uc[0] = bflo(cw.x) * bflo(uw.x); uc[1] = bfhi(cw.x) * bfhi(uw.x); uc[2] = bflo(cw.y) * bflo(uw.y); uc[3] = bfhi(cw.y) * bfhi(uw.y);
                        uc[4] = bflo(cw.z) * bflo(uw.z); uc[5] = bfhi(cw.z) * bfhi(uw.z); uc[6] = bflo(cw.w) * bflo(uw.w); uc[7] = bfhi(cw.w) * bfhi(uw.w); }
                    else if (isA) { const float* mp = METAPROJ + (size_t)(16 + tg) * NIN;
#pragma unroll
                        for (int e = 0; e < 8; ++e) uc[e] = mp[COL_C + ch + e] * mp[COL_U + ch + e]; }
                    else { const float* sp = state_conv + ((size_t)b * 2 + (2 + tg)) * CONVD + ch;
#pragma unroll
                        for (int e = 0; e < 8; ++e) uc[e] = sp[e]; }
                    if (tt >= 0) {
                        const size_t row = row0 + t; const v4u bw = *(const v4u*)(PROJ + row * NIN + COL_B + ch);
                        float bv[8] = {bflo(bw.x), bfhi(bw.x), bflo(bw.y), bfhi(bw.y), bflo(bw.z), bfhi(bw.z), bflo(bw.w), bfhi(bw.w)};
                        float y[8]; float ss = 0.f;
#pragma unroll
                        for (int e = 0; e < 8; ++e) { y[e] = bv[e] * (w0[e] * ua[e] + w1[e] * ub[e] + w2[e] * uc[e]); ss += y[e] * y[e]; }
                        const float rstd = 1.0f / sqrtf(wave_sum(ss) * (1.f / CONVD) + EPS);
                        v4u w; w.x = pk2(y[0] * rstd * gc[0], y[1] * rstd * gc[1]); w.y = pk2(y[2] * rstd * gc[2], y[3] * rstd * gc[3]); w.z = pk2(y[4] * rstd * gc[4], y[5] * rstd * gc[5]); w.w = pk2(y[6] * rstd * gc[6], y[7] * rstd * gc[7]);
                        *(v4u*)(MIX + row * D + ch) = w;
                        const int last = isA ? (c == SEQ / 64 - 1 ? 64 : 1 << 30) : 32;
                        if (t >= last - 2) { float* dst = (isA ? out + O_PC + ((size_t)b * 2 + (t - (last - 2))) * CONVD : out + O_SC + ((size_t)b * 2 + (t - (last - 2))) * CONVD) + ch;
#pragma unroll
                            for (int e = 0; e < 8; ++e) dst[e] = uc[e]; }
                    }
#pragma unroll
                    for (int e = 0; e < 8; ++e) { ua[e] = ub[e]; ub[e] = uc[e]; }
                }
            }
            __syncthreads();
        }
    }
    grid.sync();

    {
        pg8::Gemm g{MIX, WoutT, MTOT, D, D}; pg8::StaticOrder S; S.init(MTOT, D, G, bid);
        pg8::EpiOut E{x_prompt, x_sample, out, XN2, SSQ, NPROMPT};
        pg8::gemm_phase<pg8::EpiOut, pg8::StaticOrder, true, true>(lds, g, S, E);
    }
    grid.sync();

    {
        pg8::Gemm g{XN2, WupT, MTOT, FF, D}; pg8::StaticOrder S; S.init(MTOT, FF, G, bid);
        pg8::EpiUp E{HID, FF, SSQ};
        pg8::gemm_phase<pg8::EpiUp, pg8::StaticOrder, true, true>(lds, g, S, E);
    }
    grid.sync();

    {
        pg8::Gemm g{HID, WdnT, MTOT, D, FF}; pg8::StaticOrder S; S.init(MTOT, D, G, bid);
        pg8::EpiDown E{out};
        pg8::gemm_phase<pg8::EpiDown, pg8::StaticOrder, true, true>(lds, g, S, E);
    }
    grid.sync();

    {
        const int gw = bid * NWAVES + wave, NGW = G * NWAVES;
        for (int m = gw; m < MTOT; m += NGW) {
            f32x4* xr = (f32x4*)(out + (size_t)m * D) + lane; const f32x4* gr = (const f32x4*)g_final + lane;
            f32x4 v[4]; float s = 0.f;
#pragma unroll
            for (int j = 0; j < 4; ++j) { v[j] = xr[64 * j]; s += (v[j].x * v[j].x + v[j].y * v[j].y) + (v[j].z * v[j].z + v[j].w * v[j].w); }
            const float rstd = 1.0f / sqrtf(wave_sum(s) * (1.f / D) + EPS);
#pragma unroll
            for (int j = 0; j < 4; ++j) { const f32x4 gg = gr[64 * j]; xr[64 * j] = v[j] * rstd * gg; }
        }
    }
}

extern "C" void kernel_launch(void* const* d_in, const int* in_sizes, int n_in, void* d_out, int out_size, void* d_ws, size_t ws_size, hipStream_t stream) {
    static int grid = 0;
    if (grid == 0) {
        if (n_in != 20 || in_sizes[0] != NPROMPT * D || out_size != (int)O_END || ws_size < WS_END) { fprintf(stderr, "kernel_launch: unexpected shapes (n_in %d, in0 %d, out %d, ws %zu)\n", n_in, n_in > 0 ? in_sizes[0] : -1, out_size, ws_size); grid = -1; return; }
        int dev = 0, cus = 0, per_cu = 0;
        if (hipGetDevice(&dev) != hipSuccess || hipDeviceGetAttribute(&cus, hipDeviceAttributeMultiprocessorCount, dev) != hipSuccess) { grid = -1; return; }
        if (hipFuncSetAttribute((const void*)fwd_kernel, hipFuncAttributeMaxDynamicSharedMemorySize, LDS_BYTES) != hipSuccess) { fprintf(stderr, "kernel_launch: hipFuncSetAttribute failed\n"); grid = -1; return; }
        if (hipOccupancyMaxActiveBlocksPerMultiprocessor(&per_cu, (const void*)fwd_kernel, NTHREADS, LDS_BYTES) != hipSuccess || per_cu < 1) { fprintf(stderr, "kernel_launch: occupancy query says %d blocks per CU\n", per_cu); (void)hipGetLastError(); grid = -1; return; }
        grid = cus;
    }
    if (grid < 0) return;
    Params p{};
    for (int i = 0; i < 20; ++i) p.in[i] = (const float*)d_in[i];
    p.out = (float*)d_out; p.ws = (unsigned char*)d_ws;
    void* args[] = {&p};
    hipError_t e = hipLaunchCooperativeKernel((const void*)fwd_kernel, dim3(grid), dim3(NTHREADS), args, LDS_BYTES, stream);
    if (e != hipSuccess) fprintf(stderr, "kernel_launch: cooperative launch failed: %s (grid %d)\n", hipGetErrorString(e), grid);
}
```

```cpp
#include <hip/hip_runtime.h>
#include <cstdio>
#include <cstdint>
namespace pg8 {
#define PG8_LAS __attribute__((address_space(3)))
typedef unsigned short bf16_t;
typedef short bf16x8 __attribute__((ext_vector_type(8)));
typedef float f32x4 __attribute__((ext_vector_type(4)));
typedef unsigned u32x4 __attribute__((ext_vector_type(4)));
constexpr int BM = 256, BK = 64, HALF = 128, HTB = HALF * BK * 2  , STAGE_BYTES = 8 * HTB, NXCD = 8, WGM = 8;

__host__ __device__ __forceinline__ int lds_byte(int r, int c) { const int st = (r >> 4) * 2 + (c >> 5), rr = r & 15, cc = c & 31, ob = rr * 64 + cc * 2; return st * 1024 + (ob ^ (((ob >> 9) & 1) << 5)); }
__host__ __device__ __forceinline__ void stage_rc(int b, int& R, int& C) { const int st = b / 1024, sb = b % 1024, swz = sb ^ (((sb >> 9) & 1) << 5); R = (st >> 1) * 16 + swz / 64; C = (st & 1) * 32 + (swz % 64) / 2; }
__host__ __device__ __forceinline__ int perm32(int rho) { const int n = rho >> 4, i = rho & 15; return 8 * (i >> 2) + 4 * n + (i & 3); }

struct Unit { int pm, pn; };
struct Gemm { const bf16_t* A; const bf16_t* Bt; int M, N, K; };

struct StaticOrder {
    int nM, nN, nwg, G, c;
    __host__ __device__ void init(int M, int N, int G_, int c_) { nM = M / BM; nN = N / BM; nwg = nM * nN; G = G_; c = c_; }
    __host__ __device__ bool next(int i, Unit& u) const {
        const long L = (long)i * G + c; if (L >= nwg) return false;
        int wgid = (int)L; { const int q = nwg / NXCD, r = nwg % NXCD, xcd = wgid % NXCD, off = wgid / NXCD; wgid = (xcd < r ? xcd * (q + 1) : r * (q + 1) + (xcd - r) * q) + off; }
        const int nig = WGM * nN, gid = wgid / nig, fm = gid * WGM, gsz = (nM - fm) < WGM ? (nM - fm) : WGM;
        u.pm = fm + ((wgid % nig) % gsz); u.pn = (wgid % nig) / gsz; return true;
    }
    __device__ __forceinline__ void a_ready(const Unit&) const {}
    __device__ __forceinline__ void done(const Unit&) const {}
};

__device__ __forceinline__ unsigned cvt_pk_bf16(float lo, float hi) { unsigned r; asm volatile("v_cvt_pk_bf16_f32 %0, %1, %2" : "=v"(r) : "v"(lo), "v"(hi)); return r; }
typedef unsigned u32x2 __attribute__((ext_vector_type(2)));
constexpr float RMS_EPS = 1e-6f;

struct EpiProj {
    static constexpr bool PERM = true, AFTER_DRAIN = false;
    bf16_t* O; int ldc;
    __device__ __forceinline__ void operator()(const f32x4 (&acc)[2][2][4][2], const Unit& u, int wr, int wc, int fr, int fq) const {
        const int row0 = u.pm * BM + wr * 64 + fr, col0 = u.pn * BM + wc * 32 + 8 * fq;
#pragma unroll
        for (int ai = 0; ai < 2; ++ai)
#pragma unroll
            for (int m = 0; m < 4; ++m) { bf16_t* rowp = O + (size_t)(row0 + ai * HALF + m * 16) * ldc + col0;
#pragma unroll
                for (int bj = 0; bj < 2; ++bj) { const f32x4 v0 = acc[ai][bj][m][0], v1 = acc[ai][bj][m][1];
                    u32x4 w; w.x = cvt_pk_bf16(v0[0], v0[1]); w.y = cvt_pk_bf16(v0[2], v0[3]); w.z = cvt_pk_bf16(v1[0], v1[1]); w.w = cvt_pk_bf16(v1[2], v1[3]);
                    *(u32x4*)(rowp + bj * HALF) = w; } }
    }
};
struct EpiUp {
    static constexpr bool PERM = true, AFTER_DRAIN = false;
    bf16_t* O; int ldc; const float* ssq;
    __device__ __forceinline__ void operator()(const f32x4 (&acc)[2][2][4][2], const Unit& u, int wr, int wc, int fr, int fq) const {
        const int row0 = u.pm * BM + wr * 64 + fr, col0 = u.pn * BM + wc * 32 + 8 * fq;
#pragma unroll
        for (int ai = 0; ai < 2; ++ai)
#pragma unroll
            for (int m = 0; m < 4; ++m) { const int row = row0 + ai * HALF + m * 16; bf16_t* rowp = O + (size_t)row * ldc + col0;
                const f32x4* sp = (const f32x4*)(ssq + (size_t)row * 16); const f32x4 s0 = sp[0], s1 = sp[1], s2 = sp[2], s3 = sp[3];
                const float tot = ((s0[0] + s0[1]) + (s0[2] + s0[3])) + ((s1[0] + s1[1]) + (s1[2] + s1[3])) + ((s2[0] + s2[1]) + (s2[2] + s2[3])) + ((s3[0] + s3[1]) + (s3[2] + s3[3]));
                const float rs = 1.0f / sqrtf(tot * (1.0f / 1024.0f) + RMS_EPS);
#pragma unroll
                for (int bj = 0; bj < 2; ++bj) { f32x4 v0 = acc[ai][bj][m][0] * rs, v1 = acc[ai][bj][m][1] * rs;
#pragma unroll
                    for (int e = 0; e < 4; ++e) { v0[e] = fmaxf(v0[e], 0.f); v0[e] *= v0[e]; v1[e] = fmaxf(v1[e], 0.f); v1[e] *= v1[e]; }
                    u32x4 w; w.x = cvt_pk_bf16(v0[0], v0[1]); w.y = cvt_pk_bf16(v0[2], v0[3]); w.z = cvt_pk_bf16(v1[0], v1[1]); w.w = cvt_pk_bf16(v1[2], v1[3]);
                    *(u32x4*)(rowp + bj * HALF) = w; } }
    }
};
struct EpiOut {
    static constexpr bool PERM = false, AFTER_DRAIN = false;
    const float* xp; const float* xs; float* out; bf16_t* xn; float* ssq; int nprompt;
    __device__ __forceinline__ void operator()(const f32x4 (&acc)[2][2][4][2], const Unit& u, int wr, int wc, int fr, int fq) const {
        const int col0 = u.pn * BM + wc * 32 + 4 * fq;
#pragma unroll
        for (int ai = 0; ai < 2; ++ai)
#pragma unroll
            for (int m = 0; m < 4; ++m) { const int row = u.pm * BM + ai * HALF + wr * 64 + m * 16 + fr;
                const float* base = (row < nprompt) ? xp + (size_t)row * 1024 : xs + (size_t)(row - nprompt) * 1024;
                float q = 0.f;
#pragma unroll
                for (int bj = 0; bj < 2; ++bj)
#pragma unroll
                    for (int n = 0; n < 2; ++n) { const int c = col0 + bj * HALF + n * 16; const f32x4 h = *(const f32x4*)(base + c) + acc[ai][bj][m][n];
                        *(f32x4*)(out + (size_t)row * 1024 + c) = h; u32x2 w; w.x = cvt_pk_bf16(h[0], h[1]); w.y = cvt_pk_bf16(h[2], h[3]); *(u32x2*)(xn + (size_t)row * 1024 + c) = w;
                        q += (h[0] * h[0] + h[1] * h[1]) + (h[2] * h[2] + h[3] * h[3]); }
                q += __shfl_xor(q, 16); q += __shfl_xor(q, 32);
                if (fq == 0) ssq[(size_t)row * 16 + u.pn * 4 + wc] = q; }
    }
};
struct EpiDown {
    static constexpr bool PERM = false, AFTER_DRAIN = false;
    float* out;
    __device__ __forceinline__ void operator()(const f32x4 (&acc)[2][2][4][2], const Unit& u, int wr, int wc, int fr, int fq) const {
        const int col0 = u.pn * BM + wc * 32 + 4 * fq;
#pragma unroll
        for (int ai = 0; ai < 2; ++ai)
#pragma unroll
            for (int m = 0; m < 4; ++m) { const int row = u.pm * BM + ai * HALF + wr * 64 + m * 16 + fr; float* rowp = out + (size_t)row * 1024 + col0;
#pragma unroll
                for (int bj = 0; bj < 2; ++bj)
#pragma unroll
                    for (int n = 0; n < 2; ++n) { float* p = rowp + bj * HALF + n * 16; *(f32x4*)p = *(const f32x4*)p + acc[ai][bj][m][n]; } }
    }
};

template <class Epi, class Sched, bool ALIGN_EPI = false, bool SP2 = false>
__device__ __forceinline__ void gemm_phase(PG8_LAS unsigned char* lds, const Gemm g, const Sched& S, const Epi& E) {
    int tid_l = threadIdx.x; asm volatile("" : "+v"(tid_l));
    const int tid = tid_l, wid = __builtin_amdgcn_readfirstlane(tid >> 6), lane = tid & 63, wr = wid >> 2, wc = wid & 3, fr = lane & 15, fq = lane >> 4;
    const int K = g.K, nt = K / BK;
    unsigned voffA[2], voffB[2];
#pragma unroll
    for (int i = 0; i < 2; ++i) { int R, C; stage_rc(tid * 16 + i * 8192, R, C); const int Rb = Epi::PERM ? ((R & ~31) + perm32(R & 31)) : R;
        voffA[i] = (unsigned)(R * K + C) * 2u; voffB[i] = (unsigned)(Rb * K + C) * 2u; }
    const size_t kstep = (size_t)(BK * 2);
    const size_t hstep = (size_t)HALF * K * 2;
    const size_t tstep = 2 * hstep;
    const unsigned ldsw = (unsigned)wid * 1024u;
    const int aoff = lds_byte(wr * 64 + fr, fq * 8), boff = lds_byte(wc * 32 + fr, fq * 8);
#define PG8_SA(b, h) (((b) * 2 + (h)) * HTB)
#define PG8_SB(b, h) ((4 + (b) * 2 + (h)) * HTB)
#define PG8_STAGE(bufoff, gbase, voff) do { _Pragma("unroll") for (int _i = 0; _i < 2; ++_i) \
        __builtin_amdgcn_global_load_lds((const unsigned*)((const char*)(gbase) + (voff)[_i]), (PG8_LAS unsigned*)(lds + (bufoff) + ldsw + _i * 8192), 16, 0, 0); } while (0)
#define PG8_LDA(dst, b, h) do { _Pragma("unroll") for (int m = 0; m < 4; ++m) _Pragma("unroll") for (int k = 0; k < 2; ++k) dst[m][k] = *(const PG8_LAS bf16x8*)(lds + PG8_SA(b, h) + aoff + m * 2048 + k * 1024); } while (0)
#define PG8_LDB(dst, b, h) do { _Pragma("unroll") for (int n = 0; n < 2; ++n) _Pragma("unroll") for (int k = 0; k < 2; ++k) dst[n][k] = *(const PG8_LAS bf16x8*)(lds + PG8_SB(b, h) + boff + n * 2048 + k * 1024); } while (0)
#define PG8_MMA(ai, bj, At, Bt) do { __builtin_amdgcn_s_setprio(1); _Pragma("unroll") for (int m = 0; m < 4; ++m) _Pragma("unroll") for (int n = 0; n < 2; ++n) _Pragma("unroll") for (int k = 0; k < 2; ++k) \
        acc[ai][bj][m][n] = __builtin_amdgcn_mfma_f32_16x16x32_bf16(Bt[n][k], At[m][k], acc[ai][bj][m][n], 0, 0, 0); __builtin_amdgcn_s_setprio(0); } while (0)
#define PG8_WAIT_V(n) asm volatile("s_waitcnt vmcnt(" #n ")" ::: "memory")
#define PG8_WAIT_L(n) asm volatile("s_waitcnt lgkmcnt(" #n ")" ::: "memory")
#define PG8_BAR __builtin_amdgcn_s_barrier()
#define PG8_SCHED __builtin_amdgcn_sched_barrier(0)
    Unit cur, nxt; int ui = 0;
    if (!S.next(0, cur)) return;
    f32x4 acc[2][2][4][2];
#pragma unroll
    for (int a = 0; a < 2; ++a)
#pragma unroll
        for (int b = 0; b < 2; ++b)
#pragma unroll
            for (int m = 0; m < 4; ++m)
#pragma unroll
                for (int n = 0; n < 2; ++n) acc[a][b][m][n] = (f32x4){0.f, 0.f, 0.f, 0.f};
    bf16x8 At[4][2], B0[2][2], B1[2][2];
    const char* cA = (const char*)g.A + (size_t)cur.pm * tstep; const char* cB = (const char*)g.Bt + (size_t)cur.pn * tstep;
    S.a_ready(cur);
    if constexpr (SP2) {
        PG8_STAGE(PG8_SB(0, 0), cB, voffB); PG8_STAGE(PG8_SB(0, 1), cB + hstep, voffB); PG8_STAGE(PG8_SA(0, 0), cA, voffA); PG8_STAGE(PG8_SA(0, 1), cA + hstep, voffA);
        if (wr == 1) PG8_BAR;
        PG8_WAIT_V(2); PG8_BAR;
        PG8_STAGE(PG8_SB(1, 0), cB + kstep, voffB); PG8_STAGE(PG8_SA(1, 0), cA + kstep, voffA); PG8_STAGE(PG8_SB(1, 1), cB + hstep + kstep, voffB);
        PG8_WAIT_V(6); PG8_BAR;
    } else {
        PG8_STAGE(PG8_SB(0, 0), cB, voffB); PG8_STAGE(PG8_SA(0, 0), cA, voffA); PG8_STAGE(PG8_SB(0, 1), cB + hstep, voffB); PG8_STAGE(PG8_SA(0, 1), cA + hstep, voffA);
        if (wr == 1) PG8_BAR;
        PG8_WAIT_V(4); PG8_BAR;
        PG8_STAGE(PG8_SB(1, 0), cB + kstep, voffB); PG8_STAGE(PG8_SA(1, 0), cA + kstep, voffA); PG8_STAGE(PG8_SB(1, 1), cB + hstep + kstep, voffB);
        PG8_WAIT_V(6); PG8_BAR;
    }
    for (;;) {
        const bool has_next = S.next(ui + 1, nxt);
        const char* nA = has_next ? (const char*)g.A + (size_t)nxt.pm * tstep : cA; const char* nB = has_next ? (const char*)g.Bt + (size_t)nxt.pn * tstep : cB;
        for (int t = 0; t < nt; t += 2) {
            const bool last = (t == nt - 2);
            const char* a1 = cA + (size_t)(t + 1) * kstep;
            const char* a2 = last ? nA : cA + (size_t)(t + 2) * kstep; const char* b2 = last ? nB : cB + (size_t)(t + 2) * kstep;
            const char* a3 = a2 + kstep; const char* b3 = b2 + kstep;
            if (last && has_next) S.a_ready(nxt);
            if constexpr (SP2) {
            PG8_LDB(B0, 0, 0); PG8_LDB(B1, 0, 1); PG8_SCHED; PG8_LDA(At, 0, 0); PG8_STAGE(PG8_SA(1, 1), a1 + hstep, voffA);
            PG8_WAIT_V(8); PG8_WAIT_L(0); PG8_BAR; PG8_MMA(0, 0, At, B0); PG8_MMA(0, 1, At, B1); PG8_BAR; PG8_SCHED;
            PG8_LDA(At, 0, 1); PG8_STAGE(PG8_SB(0, 0), b2, voffB); PG8_STAGE(PG8_SB(0, 1), b2 + hstep, voffB); PG8_STAGE(PG8_SA(0, 0), a2, voffA);
            PG8_WAIT_V(8); PG8_WAIT_L(0); PG8_BAR; PG8_MMA(1, 0, At, B0); PG8_MMA(1, 1, At, B1); PG8_BAR; PG8_SCHED;
            PG8_LDB(B0, 1, 0); PG8_LDB(B1, 1, 1); PG8_SCHED; PG8_LDA(At, 1, 0); PG8_STAGE(PG8_SA(0, 1), a2 + hstep, voffA);
            PG8_WAIT_V(8); PG8_WAIT_L(0); PG8_BAR; PG8_MMA(0, 0, At, B0); PG8_MMA(0, 1, At, B1); PG8_BAR; PG8_SCHED;
            PG8_LDA(At, 1, 1); PG8_STAGE(PG8_SB(1, 0), b3, voffB); PG8_STAGE(PG8_SB(1, 1), b3 + hstep, voffB); PG8_STAGE(PG8_SA(1, 0), a3, voffA);
            PG8_WAIT_V(8); PG8_WAIT_L(0); PG8_BAR; PG8_MMA(1, 0, At, B0); PG8_MMA(1, 1, At, B1); PG8_BAR; PG8_SCHED;
            } else {
            PG8_LDB(B0, 0, 0); PG8_SCHED; PG8_LDA(At, 0, 0); PG8_STAGE(PG8_SA(1, 1), a1 + hstep, voffA);
            PG8_WAIT_L(8); PG8_BAR; PG8_WAIT_L(0); PG8_MMA(0, 0, At, B0); PG8_BAR; PG8_SCHED;
            PG8_LDB(B1, 0, 1); PG8_STAGE(PG8_SB(0, 0), b2, voffB);
            PG8_BAR; PG8_WAIT_L(0); PG8_MMA(0, 1, At, B1); PG8_BAR;
            PG8_LDA(At, 0, 1); PG8_STAGE(PG8_SA(0, 0), a2, voffA);
            PG8_BAR; PG8_WAIT_L(0); PG8_MMA(1, 0, At, B0); PG8_BAR; PG8_SCHED;
            PG8_STAGE(PG8_SB(0, 1), b2 + hstep, voffB);
            PG8_WAIT_V(6); PG8_BAR; PG8_MMA(1, 1, At, B1); PG8_BAR;
            PG8_LDB(B0, 1, 0); PG8_SCHED; PG8_LDA(At, 1, 0); PG8_STAGE(PG8_SA(0, 1), a2 + hstep, voffA);
            PG8_WAIT_L(8); PG8_BAR; PG8_WAIT_L(0); PG8_MMA(0, 0, At, B0); PG8_BAR; PG8_SCHED;
            PG8_LDB(B1, 1, 1); PG8_STAGE(PG8_SB(1, 0), b3, voffB);
            PG8_BAR; PG8_WAIT_L(0); PG8_MMA(0, 1, At, B1); PG8_BAR;
            PG8_LDA(At, 1, 1); PG8_STAGE(PG8_SA(1, 0), a3, voffA);
            PG8_BAR; PG8_WAIT_L(0); PG8_MMA(1, 0, At, B0); PG8_BAR; PG8_SCHED;
            PG8_STAGE(PG8_SB(1, 1), b3 + hstep, voffB);
            PG8_WAIT_V(6); PG8_BAR; PG8_MMA(1, 1, At, B1); PG8_BAR;
            }
        }
        if constexpr (ALIGN_EPI) { if (wr == 0) PG8_BAR; }
        if constexpr (!Epi::AFTER_DRAIN) { E(acc, cur, wr, wc, fr, fq); S.done(cur); }
        if (!has_next) break;
#pragma unroll
        for (int a = 0; a < 2; ++a)
#pragma unroll
            for (int b = 0; b < 2; ++b)
#pragma unroll
                for (int m = 0; m < 4; ++m)
#pragma unroll
                    for (int n = 0; n < 2; ++n) acc[a][b][m][n] = (f32x4){0.f, 0.f, 0.f, 0.f};
        cur = nxt; cA = nA; cB = nB; ++ui;
        if constexpr (ALIGN_EPI) { if (wr == 1) PG8_BAR; }
    }
    PG8_WAIT_V(0);
    if constexpr (!ALIGN_EPI) { if (wr == 0) PG8_BAR; }
    PG8_BAR;
    if constexpr (Epi::AFTER_DRAIN) { E.fused(acc, cur, wr, wc, fr, fq, lds, wid, lane); S.done(cur); }
#undef PG8_SA
#undef PG8_SB
#undef PG8_STAGE
#undef PG8_LDA
#undef PG8_LDB
#undef PG8_MMA
#undef PG8_WAIT_V
#undef PG8_WAIT_L
#undef PG8_BAR
#undef PG8_SCHED
}
}

constexpr int D = 1024, NIN = 2304, FF = 4096;
constexpr int NB = 8, SEQ = 8192, NPROMPT = NB * SEQ;
constexpr int SB = 16, SS = 32, NSAMP = SB * SS;
constexpr int MTOT = NPROMPT + NSAMP;
constexpr int NMETA = 16, CONVD = 512, QD = 512, KVD = 128, HD = 64;
constexpr int COL_B = 0, COL_C = 512, COL_U = 1024, COL_Q = 1536, COL_K = 2048, COL_V = 2176;
constexpr float EPS = 1e-6f;
constexpr float LOG2E = 1.4426950408889634f;
constexpr float C2 = 0.125f * LOG2E;
constexpr size_t O_YP = 0, O_YS = 67108864, O_PK = 67633152, O_PV = 67764224, O_PMK = 67895296, O_PMV = 67911680, O_PC = 67928064, O_SK = 67936256, O_SV = 68001792, O_SC = 68067328, O_END = 68083712;
constexpr size_t MiB = 1u << 20;
constexpr size_t WS_CTL = 0, CTL_ZERO_BYTES = 64 * 1024;
constexpr size_t WS_WIN = 2 * MiB, WS_WOUT = 8 * MiB, WS_WUP = 10 * MiB, WS_WDN = 18 * MiB;
constexpr size_t WS_METAPROJ = 26 * MiB;
constexpr size_t WS_METAKV = 26 * MiB + 256 * 1024;
constexpr size_t WS_SSQ = 27 * MiB;
constexpr size_t WS_XN2 = 32 * MiB;
constexpr size_t WS_XN0 = 161 * MiB;
constexpr size_t WS_PROJ = 290 * MiB;
constexpr size_t WS_MIX = 581 * MiB;
constexpr size_t WS_HID = 161 * MiB;
constexpr size_t WS_END = 710 * MiB;
static_assert(WS_SSQ + (size_t)MTOT * 16 * 4 <= WS_XN2 && WS_XN2 + (size_t)MTOT * D * 2 <= WS_XN0 && WS_XN0 + (size_t)MTOT * D * 2 <= WS_PROJ && WS_PROJ + (size_t)MTOT * NIN * 2 <= WS_MIX && WS_MIX + (size_t)MTOT * D * 2 <= WS_END && WS_HID + (size_t)MTOT * FF * 2 <= WS_END, "ws map");

constexpr int NWAVES = 8, NTHREADS = 512;
constexpr int LDS_BYTES = 147456;
constexpr int LDSCTL_OFF = 131072;

#define LAS __attribute__((address_space(3)))
typedef unsigned short bf16;
typedef unsigned v4u __attribute__((ext_vector_type(4)));
typedef float f32x4 __attribute__((ext_vector_type(4)));

__device__ __forceinline__ unsigned f2bf(float f) { unsigned u = __builtin_bit_cast(unsigned, f); return (u + 0x7fffu + ((u >> 16) & 1u)) >> 16; }
__device__ __forceinline__ unsigned pk2(float lo, float hi) { return f2bf(lo) | (f2bf(hi) << 16); }
__device__ __forceinline__ float bflo(unsigned w) { return __builtin_bit_cast(float, w << 16); }
__device__ __forceinline__ float bfhi(unsigned w) { return __builtin_bit_cast(float, w & 0xffff0000u); }
__device__ __forceinline__ float wave_sum(float v) {
#pragma unroll
    for (int o = 1; o < 64; o <<= 1) v += __shfl_xor(v, o);
    return v;
}

#define XB_TMO      128
#define XB_XCNT(j)  (256  + 64 * (j))
#define XB_XSUB(j)  (1280 + 64 * (j))
#define XB_XGEN(j)  (2304 + 64 * (j))
#define XB_TOP      3328
#define XB_TOPGEN   3392
#define XCD_BAR_WORDS 3456
#define XB_SPIN_CAP (1u << 18)

__device__ __forceinline__ unsigned xb_ld(unsigned* p)              { return __hip_atomic_load(p, __ATOMIC_RELAXED, __HIP_MEMORY_SCOPE_AGENT); }
__device__ __forceinline__ unsigned xb_add(unsigned* p, unsigned v) { return __hip_atomic_fetch_add(p, v, __ATOMIC_RELAXED, __HIP_MEMORY_SCOPE_AGENT); }
__device__ __forceinline__ unsigned xb_xcc_id() { return (unsigned)__builtin_amdgcn_s_getreg((3 << 11) | 20) & 0xFu; }
#define XB_SPIN(cond, bar) do { unsigned _sp = 0; while (cond) { __builtin_amdgcn_s_sleep(1); \
    if ((++_sp & 255u) == 0u) { if (xb_ld(&(bar)[XB_TMO])) break; if (_sp > XB_SPIN_CAP) { atomicAdd(&(bar)[XB_TMO], 1u); break; } } } } while (0)

struct XcdBarrier {
    unsigned* bar; unsigned x;
    volatile LAS unsigned* st;
};

__device__ __forceinline__ XcdBarrier xcd_barrier_post(unsigned* bar, volatile LAS unsigned* st) {
    XcdBarrier b; b.bar = bar; b.x = xb_xcc_id(); b.st = st;
    if (threadIdx.x == 0) (void)xb_add(&bar[XB_XCNT(b.x)], 1u);
    return b;
}
__device__ __forceinline__ void xcd_barrier_complete(unsigned* bar, unsigned x, unsigned& nloc, unsigned& nx) {
    const unsigned G = gridDim.x * gridDim.y * gridDim.z;
    unsigned sum, cnt, mine, sp = 0u;
    for (;;) {
        sum = 0u; cnt = 0u; mine = 0u;
#pragma unroll
        for (unsigned j = 0; j < 16; ++j) { const unsigned c = xb_ld(&bar[XB_XCNT(j)]); sum += c; cnt += (c > 0u) ? 1u : 0u; mine = (j == x) ? c : mine; }
        if (sum == G) break;
        __builtin_amdgcn_s_sleep(1);
        if ((++sp & 255u) == 0u) { if (xb_ld(&bar[XB_TMO])) break; if (sp > XB_SPIN_CAP) { atomicAdd(&bar[XB_TMO], 1u); break; } }
    }
    nloc = mine > 0u ? mine : 1u; nx = cnt > 0u ? cnt : 1u;
}

__device__ __forceinline__ void xcd_barrier(const XcdBarrier& b) {
    asm volatile("s_waitcnt vmcnt(0)" ::: "memory");
    __syncthreads();
    if (threadIdx.x == 0) {
        unsigned* bar = b.bar;
        __builtin_amdgcn_s_waitcnt(0);
        unsigned nloc = b.st[0], nx = b.st[1];
        if (nloc == 0u) { xcd_barrier_complete(bar, b.x, nloc, nx); b.st[0] = nloc; b.st[1] = nx; }
        const unsigned old = xb_add(&bar[XB_XSUB(b.x)], 1u);
        const unsigned gen = old / nloc;
        if (old + 1u == (gen + 1u) * nloc) {
            __builtin_amdgcn_fence(__ATOMIC_RELEASE, "agent");
            asm volatile("s_waitcnt vmcnt(0)" ::: "memory");
            const unsigned og = xb_add(&bar[XB_TOP], 1u);
            const unsigned tg = og / nx;
            if (og + 1u == (tg + 1u) * nx) xb_add(&bar[XB_TOPGEN], 1u);
            else XB_SPIN(xb_ld(&bar[XB_TOPGEN]) == tg, bar);
            __builtin_amdgcn_fence(__ATOMIC_ACQUIRE, "agent");
            xb_add(&bar[XB_XGEN(b.x)], 1u);
            asm volatile("s_waitcnt vmcnt(0)" ::: "memory");
        } else {
            XB_SPIN(xb_ld(&bar[XB_XGEN(b.x)]) == gen, bar);
            __builtin_amdgcn_fence(__ATOMIC_ACQUIRE, "agent");
            asm volatile("s_waitcnt vmcnt(0)" ::: "memory");
        }
    }
    __syncthreads();
}

struct Params {
    const float* in[20];
    float* out;
    unsigned char* ws;
};

__device__ __forceinline__ void p0_transpose_item(const float* W, int K, int N, bf16* WT, const float* gk, LAS float* scr, int item, int lane) {
    const int nblk = N / 32, kb = item / nblk, nb = item % nblk, k0 = 64 * kb, n0 = 32 * nb;
#pragma unroll 8
    for (int i = 0; i < 32; ++i) { const int kk = 2 * i + (lane >> 5); float v = W[(size_t)(k0 + kk) * N + n0 + (lane & 31)]; if (gk) v *= gk[k0 + kk]; scr[kk * 33 + (lane & 31)] = v; }
    asm volatile("s_waitcnt lgkmcnt(0)" ::: "memory");
    const int c = lane & 7;
#pragma unroll
    for (int j = 0; j < 4; ++j) { const int n = (lane >> 3) + 8 * j; const LAS float* s = scr + (8 * c) * 33 + n;
        v4u o; o.x = pk2(s[0 * 33], s[1 * 33]); o.y = pk2(s[2 * 33], s[3 * 33]); o.z = pk2(s[4 * 33], s[5 * 33]); o.w = pk2(s[6 * 33], s[7 * 33]);
        *(v4u*)(WT + (size_t)(n0 + n) * K + k0 + 8 * c) = o; }
    asm volatile("s_waitcnt lgkmcnt(0)" ::: "memory");
}
__device__ __forceinline__ void rms_row_to_bf16(const float* xrow, const float* g, bf16* orow, int lane) {
    const f32x4* xr = (const f32x4*)xrow + lane; const f32x4* gr = (const f32x4*)g + lane;
    f32x4 v[4]; float s = 0.f;
#pragma unroll
    for (int j = 0; j < 4; ++j) { v[j] = xr[64 * j]; s += (v[j].x * v[j].x + v[j].y * v[j].y) + (v[j].z * v[j].z + v[j].w * v[j].w); }
    const float rstd = 1.0f / sqrtf(wave_sum(s) * (1.f / D) + EPS);
    unsigned long long* o8 = (unsigned long long*)orow + lane;
#pragma unroll
    for (int j = 0; j < 4; ++j) { const f32x4 gg = gr[64 * j];
        o8[64 * j] = (unsigned long long)pk2(v[j].x * rstd * gg.x, v[j].y * rstd * gg.y) | ((unsigned long long)pk2(v[j].z * rstd * gg.z, v[j].w * rstd * gg.w) << 32); }
}

__device__ __forceinline__ int t5_bucket(int rel) {
    const int n = rel < 0 ? -rel : rel; int ret = rel > 0 ? 16 : 0;
    if (n < 8) return ret + n;
    int large = (31 - __clz(n * n)) + 2; if (large > 15) large = 15;
    return ret + large;
}


typedef float f32x16 __attribute__((ext_vector_type(16)));
typedef short bf16x8v __attribute__((ext_vector_type(8)));
typedef short v4i16_t __attribute__((ext_vector_type(4)));
template <int NQT>
__device__ __forceinline__ void attn_core(LAS unsigned char* KIMG, LAS unsigned char* VIMG, const LAS float* BREL, LAS float* SSQX, const bf16* PROJ, bf16* MIX, const float* g_attn, const float* sinks,
                                          size_t row0, int kt0, int ntiles, int metaoff, int wave, int lane) {
    asm volatile("" : "+v"(lane));
    const int h = wave, kvh = h >> 2, q = lane & 31, hh = lane >> 5;
    bf16x8v qf[NQT][4];
#pragma unroll
    for (int qt = 0; qt < NQT; ++qt)
#pragma unroll
        for (int ks = 0; ks < 4; ++ks) qf[qt][ks] = *(const bf16x8v*)(PROJ + (row0 + 32 * qt + q) * NIN + COL_Q + 64 * h + 16 * ks + 8 * hh);
    f32x16 O[NQT][2]; float m[NQT], l[NQT];
    const float sink2 = sinks[h] * LOG2E;
#pragma unroll
    for (int qt = 0; qt < NQT; ++qt) { m[qt] = sink2; l[qt] = hh == 0 ? 1.f : 0.f;
#pragma unroll
        for (int dt = 0; dt < 2; ++dt)
#pragma unroll
            for (int r = 0; r < 16; ++r) O[qt][dt][r] = 0.f; }
    const int kswz = q & 15;
    int koff[4];
#pragma unroll
    for (int ks = 0; ks < 4; ++ks) koff[ks] = q * 256 + (((kvh * 8 + ks * 2 + hh) ^ kswz) << 4);
    const int G4 = lane >> 4, i16 = lane & 15, vsw = (i16 >> 2) & 3;
    int voff[2];
#pragma unroll
    for (int dt = 0; dt < 2; ++dt) voff[dt] = (4 * (G4 >> 1) + (i16 >> 2)) * 256 + ((((kvh * 2 + dt) ^ vsw) << 6) | ((G4 & 1) * 32 + (i16 & 3) * 8));
    for (int kt = kt0; kt < ntiles; ++kt) {
        bf16x8v kf[4], vf[2][2];
#pragma unroll
        for (int ks = 0; ks < 4; ++ks) kf[ks] = *(const LAS bf16x8v*)(KIMG + kt * 8192 + koff[ks]);
#pragma unroll
        for (int dt = 0; dt < 2; ++dt)
#pragma unroll
            for (int s = 0; s < 2; ++s) {
                const v4i16_t a = __builtin_amdgcn_ds_read_tr16_b64_v4i16((LAS v4i16_t*)(VIMG + kt * 8192 + s * 4096 + voff[dt]));
                const v4i16_t bq = __builtin_amdgcn_ds_read_tr16_b64_v4i16((LAS v4i16_t*)(VIMG + kt * 8192 + s * 4096 + 2048 + voff[dt]));
                vf[dt][s] = (bf16x8v){a[0], a[1], a[2], a[3], bq[0], bq[1], bq[2], bq[3]}; }
        const bool lastt = (kt == ntiles - 1);
#pragma unroll
        for (int qt = 0; qt < NQT; ++qt) {
            f32x16 S;
#pragma unroll
            for (int r = 0; r < 16; ++r) S[r] = 0.f;
#pragma unroll
            for (int ks = 0; ks < 4; ++ks) S = __builtin_amdgcn_mfma_f32_32x32x16_bf16(kf[ks], qf[qt][ks], S, 0, 0, 0);
            const int i = 32 * qt + q;
            float tmax;
            if (!lastt) {
                const LAS float* bp = BREL + h * 256 + (32 * kt + 63 + 4 * hh - i);
#pragma unroll
                for (int r = 0; r < 16; ++r) S[r] = S[r] * C2 + bp[(r & 3) + 8 * (r >> 2)];
                tmax = S[0];
#pragma unroll
                for (int r = 1; r < 16; ++r) tmax = fmaxf(tmax, S[r]);
            } else {
#pragma unroll
                for (int r = 0; r < 8; ++r) { const int kr = (r & 3) + 8 * (r >> 2) + 4 * hh; int rel = kr - metaoff - i; rel = rel < -191 ? -191 : rel; S[r] = S[r] * C2 + BREL[h * 256 + rel + 191]; }
                tmax = S[0];
#pragma unroll
                for (int r = 1; r < 8; ++r) tmax = fmaxf(tmax, S[r]);
#pragma unroll
                for (int r = 8; r < 16; ++r) S[r] = -INFINITY;
            }
            tmax = fmaxf(tmax, __shfl_xor(tmax, 32));
            const float mn = fmaxf(m[qt], tmax), sc = __builtin_amdgcn_exp2f(m[qt] - mn); m[qt] = mn;
            float psum = 0.f;
#pragma unroll
            for (int r = 0; r < 16; ++r) { S[r] = __builtin_amdgcn_exp2f(S[r] - mn); psum += S[r]; }
            l[qt] = l[qt] * sc + psum;
#pragma unroll
            for (int dt = 0; dt < 2; ++dt)
#pragma unroll
                for (int r = 0; r < 16; ++r) O[qt][dt][r] *= sc;
            bf16x8v pf[2];
#pragma unroll
            for (int s = 0; s < 2; ++s) { v4u w; w.x = pg8::cvt_pk_bf16(S[8 * s + 0], S[8 * s + 1]); w.y = pg8::cvt_pk_bf16(S[8 * s + 2], S[8 * s + 3]); w.z = pg8::cvt_pk_bf16(S[8 * s + 4], S[8 * s + 5]); w.w = pg8::cvt_pk_bf16(S[8 * s + 6], S[8 * s + 7]);
                pf[s] = __builtin_bit_cast(bf16x8v, w); }
#pragma unroll
            for (int dt = 0; dt < 2; ++dt)
#pragma unroll
                for (int s = 0; s < 2; ++s) O[qt][dt] = __builtin_amdgcn_mfma_f32_32x32x16_bf16(vf[dt][s], pf[s], O[qt][dt], 0, 0, 0);
        }
    }
#pragma unroll
    for (int qt = 0; qt < NQT; ++qt) {
        const float lt = l[qt] + __shfl_xor(l[qt], 32), inv = 1.0f / lt; float ss = 0.f;
#pragma unroll
        for (int dt = 0; dt < 2; ++dt)
#pragma unroll
            for (int r = 0; r < 16; ++r) { O[qt][dt][r] *= inv; ss += O[qt][dt][r] * O[qt][dt][r]; }
        ss += __shfl_xor(ss, 32);
        if (hh == 0) SSQX[h * 64 + 32 * qt + q] = ss;
    }
    __syncthreads();
#pragma unroll
    for (int qt = 0; qt < NQT; ++qt) {
        float tot = 0.f;
#pragma unroll
        for (int h2 = 0; h2 < 8; ++h2) tot += SSQX[h2 * 64 + 32 * qt + q];
        const float rstd = 1.0f / sqrtf(tot * (1.f / QD) + EPS);
        bf16* mrow = MIX + (row0 + 32 * qt + q) * D + CONVD + 64 * h;
#pragma unroll
        for (int dt = 0; dt < 2; ++dt)
#pragma unroll
            for (int g4 = 0; g4 < 4; ++g4) { const int d0 = 32 * dt + 8 * g4 + 4 * hh; const f32x4 gv = *(const f32x4*)(g_attn + 64 * h + d0);
                pg8::u32x2 w; w.x = pg8::cvt_pk_bf16(O[qt][dt][4 * g4 + 0] * rstd * gv.x, O[qt][dt][4 * g4 + 1] * rstd * gv.y); w.y = pg8::cvt_pk_bf16(O[qt][dt][4 * g4 + 2] * rstd * gv.z, O[qt][dt][4 * g4 + 3] * rstd * gv.w);
                *(pg8::u32x2*)(mrow + d0) = w; }
    }
}

__global__ void __launch_bounds__(NTHREADS, 2) fwd_kernel(Params p) {
    extern __shared__ __attribute__((aligned(16))) unsigned char lds_raw[];
    LAS unsigned char* lds = (LAS unsigned char*)lds_raw;
    const int tid = threadIdx.x, lane = tid & 63, wave = __builtin_amdgcn_readfirstlane(tid >> 6);
    const int G = gridDim.x, bid = blockIdx.x;
    if (tid < 16) ((LAS unsigned*)(lds + LDSCTL_OFF))[tid] = 0u;
    __syncthreads();
    const XcdBarrier bar = xcd_barrier_post((unsigned*)(p.ws + WS_CTL) + 1024, (volatile LAS unsigned*)(lds + LDSCTL_OFF));
    unsigned char* ws = p.ws;
    const float* x_prompt = p.in[0]; const float* x_sample = p.in[1];
    const float* cache_k = p.in[2]; const float* cache_v = p.in[3]; const float* cache_mk = p.in[4]; const float* cache_mv = p.in[5];
    const float* state_conv = p.in[6]; const float* meta_tokens = p.in[7]; const float* g_mix = p.in[8]; const float* w_in = p.in[9];
    const float* conv_w = p.in[10]; const float* sinks = p.in[11]; const float* rel_table = p.in[12]; const float* g_conv = p.in[13];
    const float* g_attn = p.in[14]; const float* w_out = p.in[15]; const float* g_mlp = p.in[16]; const float* w_up = p.in[17];
    const float* w_down = p.in[18]; const float* g_final = p.in[19];
    float* out = p.out;
    bf16* WinT = (bf16*)(ws + WS_WIN); bf16* WoutT = (bf16*)(ws + WS_WOUT); bf16* WupT = (bf16*)(ws + WS_WUP); bf16* WdnT = (bf16*)(ws + WS_WDN);
    float* METAPROJ = (float*)(ws + WS_METAPROJ); bf16* METAKV = (bf16*)(ws + WS_METAKV); float* SSQ = (float*)(ws + WS_SSQ);
    bf16* XN0 = (bf16*)(ws + WS_XN0); bf16* PROJ = (bf16*)(ws + WS_PROJ); bf16* MIX = (bf16*)(ws + WS_MIX); bf16* XN2 = (bf16*)(ws + WS_XN2); bf16* HID = (bf16*)(ws + WS_HID);

    {
        if (bid < NIN / 64) {
            LAS float* xnT = (LAS float*)lds;
            LAS float* red = (LAS float*)(lds + 65536);
            for (int rr = 0; rr < 2; ++rr) { const int r = 2 * wave + rr; const f32x4* xr = (const f32x4*)(meta_tokens + (size_t)r * D) + lane; const f32x4* gr = (const f32x4*)g_mix + lane;
                f32x4 v[4]; float s = 0.f;
#pragma unroll
                for (int j = 0; j < 4; ++j) { v[j] = xr[64 * j]; s += (v[j].x * v[j].x + v[j].y * v[j].y) + (v[j].z * v[j].z + v[j].w * v[j].w); }
                const float rstd = 1.0f / sqrtf(wave_sum(s) * (1.f / D) + EPS);
#pragma unroll
                for (int j = 0; j < 4; ++j) { const f32x4 gg = gr[64 * j]; const int k = 4 * lane + 256 * j;
                    xnT[(k + 0) * 16 + r] = v[j].x * rstd * gg.x; xnT[(k + 1) * 16 + r] = v[j].y * rstd * gg.y; xnT[(k + 2) * 16 + r] = v[j].z * rstd * gg.z; xnT[(k + 3) * 16 + r] = v[j].w * rstd * gg.w; } }
            __syncthreads();
            const int n = 64 * bid + lane; float acc[16];
#pragma unroll
            for (int r = 0; r < 16; ++r) acc[r] = 0.f;
            for (int k = 128 * wave; k < 128 * wave + 128; ++k) { const float wv = w_in[(size_t)k * NIN + n]; const LAS f32x4* xs = (const LAS f32x4*)(xnT + k * 16);
#pragma unroll
                for (int q = 0; q < 4; ++q) { const f32x4 xv = xs[q]; acc[4 * q + 0] += xv.x * wv; acc[4 * q + 1] += xv.y * wv; acc[4 * q + 2] += xv.z * wv; acc[4 * q + 3] += xv.w * wv; } }
#pragma unroll
            for (int r = 0; r < 16; ++r) red[(wave * 16 + r) * 64 + lane] = acc[r];
            __syncthreads();
            for (int o = tid; o < 1024; o += NTHREADS) { const int r = o >> 6, l = o & 63; float s = 0.f;
#pragma unroll
                for (int w = 0; w < 8; ++w) s += red[(w * 16 + r) * 64 + l];
                const int nn = 64 * bid + l; METAPROJ[r * NIN + nn] = s;
                if (nn >= COL_K) { const int kc = nn - COL_K; METAKV[r * 256 + kc] = (bf16)f2bf(s);
                    float* dst = (kc < 128) ? out + O_PMK + r * 128 + kc : out + O_PMV + r * 128 + (kc - 128);
#pragma unroll
                    for (int b = 0; b < NB; ++b) dst[(size_t)b * NMETA * 128] = s; } }
            __syncthreads();
        }
        LAS float* scr = (LAS float*)(lds + wave * 16384);
        const int gw = bid * NWAVES + wave, NGW = G * NWAVES;
        constexpr int I_IN = (D / 64) * (NIN / 32), I_OUT = (D / 64) * (D / 32), I_UP = (D / 64) * (FF / 32), I_DN = (FF / 64) * (D / 32);
        constexpr int NITEMS = I_IN + I_OUT + I_UP + I_DN;
        for (int it = gw; it < NITEMS; it += NGW) {
            int r = it;
            if (r < I_IN) { p0_transpose_item(w_in, D, NIN, WinT, nullptr, scr, r, lane); continue; } r -= I_IN;
            if (r < I_OUT) { p0_transpose_item(w_out, D, D, WoutT, nullptr, scr, r, lane); continue; } r -= I_OUT;
            if (r < I_UP) { p0_transpose_item(w_up, D, FF, WupT, g_mlp, scr, r, lane); continue; } r -= I_UP;
            p0_transpose_item(w_down, FF, D, WdnT, nullptr, scr, r, lane);
        }
        for (int m = gw; m < MTOT; m += NGW) {
            const float* xrow = (m < NPROMPT) ? x_prompt + (size_t)m * D : x_sample + (size_t)(m - NPROMPT) * D;
            rms_row_to_bf16(xrow, g_mix, XN0 + (size_t)m * D, lane);
        }
    }
    xcd_barrier(bar);

    {
        pg8::Gemm g{XN0, WinT, MTOT, NIN, D}; pg8::StaticOrder S; S.init(MTOT, NIN, G, bid);
        pg8::EpiProj E{PROJ, NIN};
        pg8::gemm_phase<pg8::EpiProj, pg8::StaticOrder, true, true>(lds, g, S, E);
    }
    xcd_barrier(bar);

    {
        LAS unsigned char* KIMG = lds;
        LAS unsigned char* VIMG = lds + 57344;
        LAS float* BREL = (LAS float*)(lds + 114688);
        LAS float* SSQX = (LAS float*)(lds + 114688 + 8192);
        for (int o = tid; o < 8 * 256; o += NTHREADS) { const int h = o >> 8, idx = o & 255; const int rel = idx - 191; BREL[o] = (idx < 255) ? rel_table[t5_bucket(rel) * 8 + h] * LOG2E : 0.f; }
        __syncthreads();
        const int NUNITS = NB * (SEQ / 64) + SB;
        for (int u = bid; u < NUNITS; u += G) {
            const bool isA = u < NB * (SEQ / 64);
            const int b = isA ? u / (SEQ / 64) : u - NB * (SEQ / 64);
            const int c = isA ? u % (SEQ / 64) : 0;
            const int ntok = isA ? 64 : 32, nwin = isA ? 192 : 160, nk = nwin + 16, ntiles = isA ? 7 : 6;
            const size_t row0 = isA ? (size_t)b * SEQ + 64 * c : (size_t)NPROMPT + 32 * b;
            for (int ch = tid; ch < ntiles * 32 * 32; ch += NTHREADS) { const int j = ch >> 5, cc = ch & 31;
                v4u val = (v4u){0u, 0u, 0u, 0u};
                if (j < nk) {
                    if (isA) {
                        if (j < 192) { const int tk = 64 * (c - 2) + j; if (tk >= 0) val = *(const v4u*)(PROJ + ((size_t)b * SEQ + tk) * NIN + COL_K + 8 * cc); }
                        else val = *(const v4u*)(METAKV + (j - 192) * 256 + 8 * cc);
                    } else {
                        const float* src = nullptr;
                        if (j < 128) src = (cc < 16 ? cache_k : cache_v) + ((size_t)b * 128 + j) * 128 + 8 * (cc & 15);
                        else if (j >= 160) src = (cc < 16 ? cache_mk : cache_mv) + ((size_t)b * 16 + (j - 160)) * 128 + 8 * (cc & 15);
                        if (src) { const f32x4 a = *(const f32x4*)src, bb = *(const f32x4*)(src + 4); val.x = pk2(a.x, a.y); val.y = pk2(a.z, a.w); val.z = pk2(bb.x, bb.y); val.w = pk2(bb.z, bb.w); }
                        else val = *(const v4u*)(PROJ + (row0 + (j - 128)) * NIN + COL_K + 8 * cc);
                    }
                }
                if (cc < 16) *(LAS v4u*)(KIMG + j * 256 + ((cc ^ (j & 15)) << 4)) = val;
                else { const int c2 = cc - 16; *(LAS v4u*)(VIMG + j * 256 + (((((c2 >> 2) ^ (j & 3)) << 2) | (c2 & 3)) << 4)) = val; } }
            __syncthreads();
            if (isA) { if (c >= 126) { for (int o = tid; o < 64 * 256; o += NTHREADS) { const int i = o >> 8, col = o & 255; const float v = __builtin_bit_cast(float, (unsigned)PROJ[(row0 + i) * NIN + COL_K + col] << 16); const int t = 64 * (c - 126) + i;
                    if (col < 128) out[O_PK + ((size_t)b * 128 + t) * 128 + col] = v; else out[O_PV + ((size_t)b * 128 + t) * 128 + (col - 128)] = v; } } }
            else { for (int o = tid; o < 32 * 256; o += NTHREADS) { const int i = o >> 8, col = o & 255; const float v = __builtin_bit_cast(float, (unsigned)PROJ[(row0 + i) * NIN + COL_K + col] << 16);
                    if (col < 128) out[O_SK + ((size_t)b * 32 + i) * 128 + col] = v; else out[O_SV + ((size_t)b * 32 + i) * 128 + (col - 128)] = v; } }
            if (isA) attn_core<2>(KIMG, VIMG, BREL, SSQX, PROJ, MIX, g_attn, sinks, row0, (c >= 2 ? 0 : 4 - 2 * c), 7, 16 + 64 * c, wave, lane);
            else     attn_core<1>(KIMG, VIMG, BREL, SSQX, PROJ, MIX, g_attn, sinks, row0, 0, 6, 16 + 4096, wave, lane);
            {
                const int tpw = ntok / 8, ch = 8 * lane;
                float w0[8], w1[8], w2[8], gc[8];
#pragma unroll
                for (int e = 0; e < 8; ++e) { w0[e] = conv_w[ch + e]; w1[e] = conv_w[CONVD + ch + e]; w2[e] = conv_w[2 * CONVD + ch + e]; gc[e] = g_conv[ch + e]; }
                float ua[8] = {0.f, 0.f, 0.f, 0.f, 0.f, 0.f, 0.f, 0.f}, ub[8] = {0.f, 0.f, 0.f, 0.f, 0.f, 0.f, 0.f, 0.f}, uc[8];
                for (int tt = -2; tt < tpw; ++tt) {
                    const int t = tpw * wave + tt;
                    const int tg = isA ? 64 * c + t : t;
                    if (tg >= 0) { const bf16* pr = PROJ + (isA ? (size_t)b * SEQ + tg : (size_t)NPROMPT + 32 * b + tg) * NIN;
                        const v4u cw = *(const v4u*)(pr + COL_C + ch), uw = *(const v4u*)(pr + COL_U + ch);
                        uc[0] = bflo(cw.x) * bflo(uw.x); uc[1] = bfhi(cw.x) * bfhi(uw.x); uc[2] = bflo(cw.y) * bflo(uw.y); uc[3] = bfhi(cw.y) * bfhi(uw.y);
                        uc[4] = bflo(cw.z) * bflo(uw.z); uc[5] = bfhi(cw.z) * bfhi(uw.z); uc[6] = bflo(cw.w) * bflo(uw.w); uc[7] = bfhi(cw.w) * bfhi(uw.w); }
                    else if (isA) { const float* mp = METAPROJ + (size_t)(16 + tg) * NIN;
#pragma unroll
                        for (int e = 0; e < 8; ++e) uc[e] = mp[COL_C + ch + e] * mp[COL_U + ch + e]; }
                    else { const float* sp = state_conv + ((size_t)b * 2 + (2 + tg)) * CONVD + ch;
#pragma unroll
                        for (int e = 0; e < 8; ++e) uc[e] = sp[e]; }
                    if (tt >= 0) {
                        const size_t row = row0 + t; const v4u bw = *(const v4u*)(PROJ + row * NIN + COL_B + ch);
                        float bv[8] = {bflo(bw.x), bfhi(bw.x), bflo(bw.y), bfhi(bw.y), bflo(bw.z), bfhi(bw.z), bflo(bw.w), bfhi(bw.w)};
                        float y[8]; float ss = 0.f;
#pragma unroll
                        for (int e = 0; e < 8; ++e) { y[e] = bv[e] * (w0[e] * ua[e] + w1[e] * ub[e] + w2[e] * uc[e]); ss += y[e] * y[e]; }
                        const float rstd = 1.0f / sqrtf(wave_sum(ss) * (1.f / CONVD) + EPS);
                        v4u w; w.x = pk2(y[0] * rstd * gc[0], y[1] * rstd * gc[1]); w.y = pk2(y[2] * rstd * gc[2], y[3] * rstd * gc[3]); w.z = pk2(y[4] * rstd * gc[4], y[5] * rstd * gc[5]); w.w = pk2(y[6] * rstd * gc[6], y[7] * rstd * gc[7]);
                        *(v4u*)(MIX + row * D + ch) = w;
                        const int last = isA ? (c == SEQ / 64 - 1 ? 64 : 1 << 30) : 32;
                        if (t >= last - 2) { float* dst = (isA ? out + O_PC + ((size_t)b * 2 + (t - (last - 2))) * CONVD : out + O_SC + ((size_t)b * 2 + (t - (last - 2))) * CONVD) + ch;
#pragma unroll
                            for (int e = 0; e < 8; ++e) dst[e] = uc[e]; }
                    }
#pragma unroll
                    for (int e = 0; e < 8; ++e) { ua[e] = ub[e]; ub[e] = uc[e]; }
                }
            }
            __syncthreads();
        }
    }
    xcd_barrier(bar);

    {
        pg8::Gemm g{MIX, WoutT, MTOT, D, D}; pg8::StaticOrder S; S.init(MTOT, D, G, bid);
        pg8::EpiOut E{x_prompt, x_sample, out, XN2, SSQ, NPROMPT};
        pg8::gemm_phase<pg8::EpiOut, pg8::StaticOrder, true, true>(lds, g, S, E);
    }
    xcd_barrier(bar);

    {
        pg8::Gemm g{XN2, WupT, MTOT, FF, D}; pg8::StaticOrder S; S.init(MTOT, FF, G, bid);
        pg8::EpiUp E{HID, FF, SSQ};
        pg8::gemm_phase<pg8::EpiUp, pg8::StaticOrder, true, true>(lds, g, S, E);
    }
    xcd_barrier(bar);

    {
        pg8::Gemm g{HID, WdnT, MTOT, D, FF}; pg8::StaticOrder S; S.init(MTOT, D, G, bid);
        pg8::EpiDown E{out};
        pg8::gemm_phase<pg8::EpiDown, pg8::StaticOrder, true, true>(lds, g, S, E);
    }
    xcd_barrier(bar);

    {
        const int gw = bid * NWAVES + wave, NGW = G * NWAVES;
        for (int m = gw; m < MTOT; m += NGW) {
            f32x4* xr = (f32x4*)(out + (size_t)m * D) + lane; const f32x4* gr = (const f32x4*)g_final + lane;
            f32x4 v[4]; float s = 0.f;
#pragma unroll
            for (int j = 0; j < 4; ++j) { v[j] = xr[64 * j]; s += (v[j].x * v[j].x + v[j].y * v[j].y) + (v[j].z * v[j].z + v[j].w * v[j].w); }
            const float rstd = 1.0f / sqrtf(wave_sum(s) * (1.f / D) + EPS);
#pragma unroll
            for (int j = 0; j < 4; ++j) { const f32x4 gg = gr[64 * j]; xr[64 * j] = v[j] * rstd * gg; }
        }
    }
}

extern "C" void kernel_launch(void* const* d_in, const int* in_sizes, int n_in, void* d_out, int out_size, void* d_ws, size_t ws_size, hipStream_t stream) {
    static int grid = 0;
    if (grid == 0) {
        if (n_in != 20 || in_sizes[0] != NPROMPT * D || out_size != (int)O_END || ws_size < WS_END) { fprintf(stderr, "kernel_launch: unexpected shapes (n_in %d, in0 %d, out %d, ws %zu)\n", n_in, n_in > 0 ? in_sizes[0] : -1, out_size, ws_size); grid = -1; return; }
        int dev = 0, cus = 0, per_cu = 0;
        if (hipGetDevice(&dev) != hipSuccess || hipDeviceGetAttribute(&cus, hipDeviceAttributeMultiprocessorCount, dev) != hipSuccess) { grid = -1; return; }
        if (hipFuncSetAttribute((const void*)fwd_kernel, hipFuncAttributeMaxDynamicSharedMemorySize, LDS_BYTES) != hipSuccess) { fprintf(stderr, "kernel_launch: hipFuncSetAttribute failed\n"); grid = -1; return; }
        if (hipOccupancyMaxActiveBlocksPerMultiprocessor(&per_cu, (const void*)fwd_kernel, NTHREADS, LDS_BYTES) != hipSuccess || per_cu < 1) { fprintf(stderr, "kernel_launch: occupancy query says %d blocks per CU\n", per_cu); (void)hipGetLastError(); grid = -1; return; }
        grid = cus;
    }
    if (grid < 0) return;
    Params p{};
    for (int i = 0; i < 20; ++i) p.in[i] = (const float*)d_in[i];
    p.out = (float*)d_out; p.ws = (unsigned char*)d_ws;
    if (hipMemsetAsync((char*)d_ws + WS_CTL, 0, CTL_ZERO_BYTES, stream) != hipSuccess) { fprintf(stderr, "kernel_launch: memset failed\n"); return; }
    hipLaunchKernelGGL(fwd_kernel, dim3(grid), dim3(NTHREADS), LDS_BYTES, stream, p);
    const hipError_t e = hipPeekAtLastError();
    if (e != hipSuccess) fprintf(stderr, "kernel_launch: launch failed: %s (grid %d)\n", hipGetErrorString(e), grid);
}
```

```cpp
#include <hip/hip_runtime.h>
#include <cstdio>
#include <cstdint>
namespace pg8 {
#define PG8_LAS __attribute__((address_space(3)))
typedef unsigned short bf16_t;
typedef short bf16x8 __attribute__((ext_vector_type(8)));
typedef float f32x4 __attribute__((ext_vector_type(4)));
typedef unsigned u32x4 __attribute__((ext_vector_type(4)));
constexpr int BM = 256, BK = 64, HALF = 128, HTB = HALF * BK * 2  , STAGE_BYTES = 8 * HTB, NXCD = 8, WGM = 8;

__host__ __device__ __forceinline__ int lds_byte(int r, int c) { const int st = (r >> 4) * 2 + (c >> 5), rr = r & 15, cc = c & 31, ob = rr * 64 + cc * 2; return st * 1024 + (ob ^ (((ob >> 9) & 1) << 5)); }
__host__ __device__ __forceinline__ void stage_rc(int b, int& R, int& C) { const int st = b / 1024, sb = b % 1024, swz = sb ^ (((sb >> 9) & 1) << 5); R = (st >> 1) * 16 + swz / 64; C = (st & 1) * 32 + (swz % 64) / 2; }
__host__ __device__ __forceinline__ int perm32(int rho) { const int n = rho >> 4, i = rho & 15; return 8 * (i >> 2) + 4 * n + (i & 3); }

struct Unit { int pm, pn, kofs, nt, ks; };
struct Gemm { const bf16_t* A; const bf16_t* Bt; int M, N, K; };

struct StaticOrder {
    int nM, nN, nwg, G, c;
    __host__ __device__ __forceinline__ void init(int M, int N, int G_, int c_) { nM = M / BM; nN = N / BM; nwg = nM * nN; G = G_; c = c_; }
    __host__ __device__ __forceinline__ bool next(int i, Unit& u) const {
        const long L = (long)i * G + c; if (L >= nwg) return false;
        int wgid = (int)L; { const int q = nwg / NXCD, r = nwg % NXCD, xcd = wgid % NXCD, off = wgid / NXCD; wgid = (xcd < r ? xcd * (q + 1) : r * (q + 1) + (xcd - r) * q) + off; }
        const int nig = WGM * nN, gid = wgid / nig, fm = gid * WGM, gsz = (nM - fm) < WGM ? (nM - fm) : WGM;
        u.pm = fm + ((wgid % nig) % gsz); u.pn = (wgid % nig) / gsz; return true;
    }
    __device__ __forceinline__ void a_ready(const Unit&) const {}
    __device__ __forceinline__ void done(const Unit&) const {}
};

template <int NMP, int NMS, int N, int K, int KSPLIT>
struct PhaseOrder {
    static constexpr int nN = N / BM, nwg = NMP * nN, ntfull = K / BK, nextra = NMS * nN * KSPLIT;
    int G, c;
    __device__ __forceinline__ void init(int G_, int c_) { G = G_; c = c_; }
    __device__ __forceinline__ Unit get(int i) const {
        const int L = i * G + c; Unit u;
        if (L < nwg) {
            int wgid = L; { constexpr int q = nwg / NXCD, r = nwg % NXCD; const int xcd = wgid % NXCD, off = wgid / NXCD; wgid = (xcd < r ? xcd * (q + 1) : r * (q + 1) + (xcd - r) * q) + off; }
            constexpr int nig = WGM * nN; const int gid = wgid / nig, fm = gid * WGM, gsz = (NMP - fm) < WGM ? (NMP - fm) : WGM;
            u.pm = fm + ((wgid % nig) % gsz); u.pn = (wgid % nig) / gsz; u.kofs = 0; u.nt = ntfull; u.ks = 0;
        } else {
            const int e = L - nwg;
            u.ks = e % KSPLIT; u.pn = (e / KSPLIT) % nN; u.pm = NMP + e / (KSPLIT * nN); u.nt = (e < nextra) ? ntfull / KSPLIT : 0; u.kofs = u.ks * (ntfull / KSPLIT) * BK;
        }
        return u;
    }
    __device__ __forceinline__ void a_ready(const Unit&) const {}
    __device__ __forceinline__ void done(const Unit&) const {}
};
__device__ __forceinline__ unsigned cvt_pk_bf16(float lo, float hi) { unsigned r; asm volatile("v_cvt_pk_bf16_f32 %0, %1, %2" : "=v"(r) : "v"(lo), "v"(hi)); return r; }
typedef unsigned u32x2 __attribute__((ext_vector_type(2)));
constexpr float RMS_EPS = 1e-6f;

struct EpiProj {
    static constexpr bool PERM = true, AFTER_DRAIN = false;
    bf16_t* O; int ldc;
    __device__ __forceinline__ void operator()(const f32x4 (&acc)[2][2][4][2], const Unit& u, int wr, int wc, int fr, int fq) const {
        const int row0 = u.pm * BM + wr * 64 + fr, col0 = u.pn * BM + wc * 32 + 8 * fq;
#pragma unroll
        for (int ai = 0; ai < 2; ++ai)
#pragma unroll
            for (int m = 0; m < 4; ++m) { bf16_t* rowp = O + (size_t)(row0 + ai * HALF + m * 16) * ldc + col0;
#pragma unroll
                for (int bj = 0; bj < 2; ++bj) { const f32x4 v0 = acc[ai][bj][m][0], v1 = acc[ai][bj][m][1];
                    u32x4 w; w.x = cvt_pk_bf16(v0[0], v0[1]); w.y = cvt_pk_bf16(v0[2], v0[3]); w.z = cvt_pk_bf16(v1[0], v1[1]); w.w = cvt_pk_bf16(v1[2], v1[3]);
                    *(u32x4*)(rowp + bj * HALF) = w; } }
    }
};
struct EpiUp {
    static constexpr bool PERM = true, AFTER_DRAIN = false;
    bf16_t* O; int ldc; const float* ssq;
    __device__ __forceinline__ void operator()(const f32x4 (&acc)[2][2][4][2], const Unit& u, int wr, int wc, int fr, int fq) const {
        const int row0 = u.pm * BM + wr * 64 + fr, col0 = u.pn * BM + wc * 32 + 8 * fq;
#pragma unroll
        for (int ai = 0; ai < 2; ++ai)
#pragma unroll
            for (int m = 0; m < 4; ++m) { const int row = row0 + ai * HALF + m * 16; bf16_t* rowp = O + (size_t)row * ldc + col0;
                const f32x4* sp = (const f32x4*)(ssq + (size_t)row * 16); const f32x4 s0 = sp[0], s1 = sp[1], s2 = sp[2], s3 = sp[3];
                const float tot = ((s0[0] + s0[1]) + (s0[2] + s0[3])) + ((s1[0] + s1[1]) + (s1[2] + s1[3])) + ((s2[0] + s2[1]) + (s2[2] + s2[3])) + ((s3[0] + s3[1]) + (s3[2] + s3[3]));
                const float rs = 1.0f / sqrtf(tot * (1.0f / 1024.0f) + RMS_EPS);
#pragma unroll
                for (int bj = 0; bj < 2; ++bj) { f32x4 v0 = acc[ai][bj][m][0] * rs, v1 = acc[ai][bj][m][1] * rs;
#pragma unroll
                    for (int e = 0; e < 4; ++e) { v0[e] = fmaxf(v0[e], 0.f); v0[e] *= v0[e]; v1[e] = fmaxf(v1[e], 0.f); v1[e] *= v1[e]; }
                    u32x4 w; w.x = cvt_pk_bf16(v0[0], v0[1]); w.y = cvt_pk_bf16(v0[2], v0[3]); w.z = cvt_pk_bf16(v1[0], v1[1]); w.w = cvt_pk_bf16(v1[2], v1[3]);
                    *(u32x4*)(rowp + bj * HALF) = w; } }
    }
};
struct EpiOut {
    static constexpr bool PERM = false, AFTER_DRAIN = false;
    const float* xp; const float* xs; float* out; bf16_t* xn; float* ssq; int nprompt;
    __device__ __forceinline__ void operator()(const f32x4 (&acc)[2][2][4][2], const Unit& u, int wr, int wc, int fr, int fq) const {
        const int col0 = u.pn * BM + wc * 32 + 4 * fq;
#pragma unroll
        for (int ai = 0; ai < 2; ++ai)
#pragma unroll
            for (int m = 0; m < 4; ++m) { const int row = u.pm * BM + ai * HALF + wr * 64 + m * 16 + fr;
                const float* base = (row < nprompt) ? xp + (size_t)row * 1024 : xs + (size_t)(row - nprompt) * 1024;
                float q = 0.f;
#pragma unroll
                for (int bj = 0; bj < 2; ++bj)
#pragma unroll
                    for (int n = 0; n < 2; ++n) { const int c = col0 + bj * HALF + n * 16; const f32x4 h = *(const f32x4*)(base + c) + acc[ai][bj][m][n];
                        *(f32x4*)(out + (size_t)row * 1024 + c) = h; u32x2 w; w.x = cvt_pk_bf16(h[0], h[1]); w.y = cvt_pk_bf16(h[2], h[3]); *(u32x2*)(xn + (size_t)row * 1024 + c) = w;
                        q += (h[0] * h[0] + h[1] * h[1]) + (h[2] * h[2] + h[3] * h[3]); }
                q += __shfl_xor(q, 16); q += __shfl_xor(q, 32);
                if (fq == 0) ssq[(size_t)row * 16 + u.pn * 4 + wc] = q; }
    }
};
struct EpiDown {
    static constexpr bool PERM = false, AFTER_DRAIN = false;
    float* out; float* slab; int nMp; int nsrows;
    __device__ __forceinline__ void operator()(const f32x4 (&acc)[2][2][4][2], const Unit& u, int wr, int wc, int fr, int fq) const {
        const int col0 = u.pn * BM + wc * 32 + 4 * fq;
        if (u.pm < nMp) {
#pragma unroll
            for (int ai = 0; ai < 2; ++ai)
#pragma unroll
                for (int m = 0; m < 4; ++m) { const int row = u.pm * BM + ai * HALF + wr * 64 + m * 16 + fr; float* rowp = out + (size_t)row * 1024 + col0;
#pragma unroll
                    for (int bj = 0; bj < 2; ++bj)
#pragma unroll
                        for (int n = 0; n < 2; ++n) { float* p = rowp + bj * HALF + n * 16; *(f32x4*)p = *(const f32x4*)p + acc[ai][bj][m][n]; } }
        } else {
            float* sl = slab + (size_t)u.ks * nsrows * 1024;
#pragma unroll
            for (int ai = 0; ai < 2; ++ai)
#pragma unroll
                for (int m = 0; m < 4; ++m) { const int row = (u.pm - nMp) * BM + ai * HALF + wr * 64 + m * 16 + fr; float* rowp = sl + (size_t)row * 1024 + col0;
#pragma unroll
                    for (int bj = 0; bj < 2; ++bj)
#pragma unroll
                        for (int n = 0; n < 2; ++n) *(f32x4*)(rowp + bj * HALF + n * 16) = acc[ai][bj][m][n]; }
        }
    }
};

template <class Epi, class Sched, bool ALIGN_EPI = false, bool SP2 = false>
__device__ __forceinline__ void gemm_phase(PG8_LAS unsigned char* lds, const Gemm g, const Sched& S, const Epi& E) {
    int tid_l = threadIdx.x; asm volatile("" : "+v"(tid_l));
    const int tid = tid_l, wid = __builtin_amdgcn_readfirstlane(tid >> 6), lane = tid & 63, wr = wid >> 2, wc = wid & 3, fr = lane & 15, fq = lane >> 4;
    const int K = g.K;
    unsigned voffA[2], voffB[2];
#pragma unroll
    for (int i = 0; i < 2; ++i) { int R, C; stage_rc(tid * 16 + i * 8192, R, C); const int Rb = Epi::PERM ? ((R & ~31) + perm32(R & 31)) : R;
        voffA[i] = (unsigned)(R * K + C) * 2u; voffB[i] = (unsigned)(Rb * K + C) * 2u; }
    const size_t kstep = (size_t)(BK * 2);
    const size_t hstep = (size_t)HALF * K * 2;
    const size_t tstep = 2 * hstep;
    const unsigned ldsw = (unsigned)wid * 1024u;
    const int aoff = lds_byte(wr * 64 + fr, fq * 8), boff = lds_byte(wc * 32 + fr, fq * 8);
#define PG8_SA(b, h) (((b) * 2 + (h)) * HTB)
#define PG8_SB(b, h) ((4 + (b) * 2 + (h)) * HTB)
#define PG8_STAGE(bufoff, gbase, voff) do { _Pragma("unroll") for (int _i = 0; _i < 2; ++_i) \
        __builtin_amdgcn_global_load_lds((const unsigned*)((const char*)(gbase) + (voff)[_i]), (PG8_LAS unsigned*)(lds + (bufoff) + ldsw + _i * 8192), 16, 0, 0); } while (0)
#define PG8_LDA(dst, b, h) do { _Pragma("unroll") for (int m = 0; m < 4; ++m) _Pragma("unroll") for (int k = 0; k < 2; ++k) dst[m][k] = *(const PG8_LAS bf16x8*)(lds + PG8_SA(b, h) + aoff + m * 2048 + k * 1024); } while (0)
#define PG8_LDB(dst, b, h) do { _Pragma("unroll") for (int n = 0; n < 2; ++n) _Pragma("unroll") for (int k = 0; k < 2; ++k) dst[n][k] = *(const PG8_LAS bf16x8*)(lds + PG8_SB(b, h) + boff + n * 2048 + k * 1024); } while (0)
#define PG8_MMA(ai, bj, At, Bt) do { __builtin_amdgcn_s_setprio(1); _Pragma("unroll") for (int m = 0; m < 4; ++m) _Pragma("unroll") for (int n = 0; n < 2; ++n) _Pragma("unroll") for (int k = 0; k < 2; ++k) \
        acc[ai][bj][m][n] = __builtin_amdgcn_mfma_f32_16x16x32_bf16(Bt[n][k], At[m][k], acc[ai][bj][m][n], 0, 0, 0); __builtin_amdgcn_s_setprio(0); } while (0)
#define PG8_WAIT_V(n) asm volatile("s_waitcnt vmcnt(" #n ")" ::: "memory")
#define PG8_WAIT_L(n) asm volatile("s_waitcnt lgkmcnt(" #n ")" ::: "memory")
#define PG8_BAR __builtin_amdgcn_s_barrier()
#define PG8_SCHED __builtin_amdgcn_sched_barrier(0)
    Unit cur = S.get(0), nxt; int ui = 0;
    if (cur.nt == 0) return;
    f32x4 acc[2][2][4][2];
#pragma unroll
    for (int a = 0; a < 2; ++a)
#pragma unroll
        for (int b = 0; b < 2; ++b)
#pragma unroll
            for (int m = 0; m < 4; ++m)
#pragma unroll
                for (int n = 0; n < 2; ++n) acc[a][b][m][n] = (f32x4){0.f, 0.f, 0.f, 0.f};
    bf16x8 At[4][2], B0[2][2], B1[2][2];
    const char* cA = (const char*)g.A + (size_t)cur.pm * tstep + (size_t)cur.kofs * 2; const char* cB = (const char*)g.Bt + (size_t)cur.pn * tstep + (size_t)cur.kofs * 2;
    S.a_ready(cur);
    if constexpr (SP2) {
        PG8_STAGE(PG8_SB(0, 0), cB, voffB); PG8_STAGE(PG8_SB(0, 1), cB + hstep, voffB); PG8_STAGE(PG8_SA(0, 0), cA, voffA); PG8_STAGE(PG8_SA(0, 1), cA + hstep, voffA);
        if (wr == 1) PG8_BAR;
        PG8_WAIT_V(2); PG8_BAR;
        PG8_STAGE(PG8_SB(1, 0), cB + kstep, voffB); PG8_STAGE(PG8_SA(1, 0), cA + kstep, voffA); PG8_STAGE(PG8_SB(1, 1), cB + hstep + kstep, voffB);
        PG8_WAIT_V(6); PG8_BAR;
    } else {
        PG8_STAGE(PG8_SB(0, 0), cB, voffB); PG8_STAGE(PG8_SA(0, 0), cA, voffA); PG8_STAGE(PG8_SB(0, 1), cB + hstep, voffB); PG8_STAGE(PG8_SA(0, 1), cA + hstep, voffA);
        if (wr == 1) PG8_BAR;
        PG8_WAIT_V(4); PG8_BAR;
        PG8_STAGE(PG8_SB(1, 0), cB + kstep, voffB); PG8_STAGE(PG8_SA(1, 0), cA + kstep, voffA); PG8_STAGE(PG8_SB(1, 1), cB + hstep + kstep, voffB);
        PG8_WAIT_V(6); PG8_BAR;
    }
    for (;;) {
        nxt = S.get(ui + 1); const bool has_next = nxt.nt != 0;
        const char* nA = has_next ? (const char*)g.A + (size_t)nxt.pm * tstep + (size_t)nxt.kofs * 2 : cA; const char* nB = has_next ? (const char*)g.Bt + (size_t)nxt.pn * tstep + (size_t)nxt.kofs * 2 : cB;
        const int nt = cur.nt;
        for (int t = 0; t < nt; t += 2) {
            const bool last = (t == nt - 2);
            const char* a1 = cA + (size_t)(t + 1) * kstep;
            const char* a2 = last ? nA : cA + (size_t)(t + 2) * kstep; const char* b2 = last ? nB : cB + (size_t)(t + 2) * kstep;
            const char* a3 = a2 + kstep; const char* b3 = b2 + kstep;
            if (last && has_next) S.a_ready(nxt);
            if constexpr (SP2) {
            PG8_LDB(B0, 0, 0); PG8_LDB(B1, 0, 1); PG8_SCHED; PG8_LDA(At, 0, 0); PG8_STAGE(PG8_SA(1, 1), a1 + hstep, voffA);
            PG8_WAIT_V(8); PG8_WAIT_L(0); PG8_BAR; PG8_MMA(0, 0, At, B0); PG8_MMA(0, 1, At, B1); PG8_BAR; PG8_SCHED;
            PG8_LDA(At, 0, 1); PG8_STAGE(PG8_SB(0, 0), b2, voffB); PG8_STAGE(PG8_SB(0, 1), b2 + hstep, voffB); PG8_STAGE(PG8_SA(0, 0), a2, voffA);
            PG8_WAIT_V(8); PG8_WAIT_L(0); PG8_BAR; PG8_MMA(1, 0, At, B0); PG8_MMA(1, 1, At, B1); PG8_BAR; PG8_SCHED;
            PG8_LDB(B0, 1, 0); PG8_LDB(B1, 1, 1); PG8_SCHED; PG8_LDA(At, 1, 0); PG8_STAGE(PG8_SA(0, 1), a2 + hstep, voffA);
            PG8_WAIT_V(8); PG8_WAIT_L(0); PG8_BAR; PG8_MMA(0, 0, At, B0); PG8_MMA(0, 1, At, B1); PG8_BAR; PG8_SCHED;
            PG8_LDA(At, 1, 1); PG8_STAGE(PG8_SB(1, 0), b3, voffB); PG8_STAGE(PG8_SB(1, 1), b3 + hstep, voffB); PG8_STAGE(PG8_SA(1, 0), a3, voffA);
            PG8_WAIT_V(8); PG8_WAIT_L(0); PG8_BAR; PG8_MMA(1, 0, At, B0); PG8_MMA(1, 1, At, B1); PG8_BAR; PG8_SCHED;
            } else {
            PG8_LDB(B0, 0, 0); PG8_SCHED; PG8_LDA(At, 0, 0); PG8_STAGE(PG8_SA(1, 1), a1 + hstep, voffA);
            PG8_WAIT_L(8); PG8_BAR; PG8_WAIT_L(0); PG8_MMA(0, 0, At, B0); PG8_BAR; PG8_SCHED;
            PG8_LDB(B1, 0, 1); PG8_STAGE(PG8_SB(0, 0), b2, voffB);
            PG8_BAR; PG8_WAIT_L(0); PG8_MMA(0, 1, At, B1); PG8_BAR;
            PG8_LDA(At, 0, 1); PG8_STAGE(PG8_SA(0, 0), a2, voffA);
            PG8_BAR; PG8_WAIT_L(0); PG8_MMA(1, 0, At, B0); PG8_BAR; PG8_SCHED;
            PG8_STAGE(PG8_SB(0, 1), b2 + hstep, voffB);
            PG8_WAIT_V(6); PG8_BAR; PG8_MMA(1, 1, At, B1); PG8_BAR;
            PG8_LDB(B0, 1, 0); PG8_SCHED; PG8_LDA(At, 1, 0); PG8_STAGE(PG8_SA(0, 1), a2 + hstep, voffA);
            PG8_WAIT_L(8); PG8_BAR; PG8_WAIT_L(0); PG8_MMA(0, 0, At, B0); PG8_BAR; PG8_SCHED;
            PG8_LDB(B1, 1, 1); PG8_STAGE(PG8_SB(1, 0), b3, voffB);
            PG8_BAR; PG8_WAIT_L(0); PG8_MMA(0, 1, At, B1); PG8_BAR;
            PG8_LDA(At, 1, 1); PG8_STAGE(PG8_SA(1, 0), a3, voffA);
            PG8_BAR; PG8_WAIT_L(0); PG8_MMA(1, 0, At, B0); PG8_BAR; PG8_SCHED;
            PG8_STAGE(PG8_SB(1, 1), b3 + hstep, voffB);
            PG8_WAIT_V(6); PG8_BAR; PG8_MMA(1, 1, At, B1); PG8_BAR;
            }
        }
        if constexpr (ALIGN_EPI) { if (wr == 0) PG8_BAR; }
        if constexpr (!Epi::AFTER_DRAIN) { E(acc, cur, wr, wc, fr, fq); S.done(cur); }
        if (!has_next) break;
#pragma unroll
        for (int a = 0; a < 2; ++a)
#pragma unroll
            for (int b = 0; b < 2; ++b)
#pragma unroll
                for (int m = 0; m < 4; ++m)
#pragma unroll
                    for (int n = 0; n < 2; ++n) acc[a][b][m][n] = (f32x4){0.f, 0.f, 0.f, 0.f};
        cur = nxt; cA = nA; cB = nB; ++ui;
        if constexpr (ALIGN_EPI) { if (wr == 1) PG8_BAR; }
    }
    PG8_WAIT_V(0);
    if constexpr (!ALIGN_EPI) { if (wr == 0) PG8_BAR; }
    PG8_BAR;
    if constexpr (Epi::AFTER_DRAIN) { E.fused(acc, cur, wr, wc, fr, fq, lds, wid, lane); S.done(cur); }
#undef PG8_SA
#undef PG8_SB
#undef PG8_STAGE
#undef PG8_LDA
#undef PG8_LDB
#undef PG8_MMA
#undef PG8_WAIT_V
#undef PG8_WAIT_L
#undef PG8_BAR
#undef PG8_SCHED
}
}

constexpr int D = 1024, NIN = 2304, FF = 4096;
constexpr int NB = 8, SEQ = 8192, NPROMPT = NB * SEQ;
constexpr int SB = 16, SS = 32, NSAMP = SB * SS;
constexpr int MTOT = NPROMPT + NSAMP;
constexpr int NMETA = 16, CONVD = 512, QD = 512, KVD = 128, HD = 64;
constexpr int COL_B = 0, COL_C = 512, COL_U = 1024, COL_Q = 1536, COL_K = 2048, COL_V = 2176;
constexpr float EPS = 1e-6f;
constexpr float LOG2E = 1.4426950408889634f;
constexpr float C2 = 0.125f * LOG2E;
constexpr size_t O_YP = 0, O_YS = 67108864, O_PK = 67633152, O_PV = 67764224, O_PMK = 67895296, O_PMV = 67911680, O_PC = 67928064, O_SK = 67936256, O_SV = 68001792, O_SC = 68067328, O_END = 68083712;
constexpr size_t MiB = 1u << 20;
constexpr size_t WS_CTL = 0, CTL_ZERO_BYTES = 64 * 1024;
constexpr size_t WS_WIN = 2 * MiB, WS_WOUT = 8 * MiB, WS_WUP = 10 * MiB, WS_WDN = 18 * MiB;
constexpr size_t WS_METAPROJ = 26 * MiB;
constexpr size_t WS_METAKV = 26 * MiB + 256 * 1024;
constexpr size_t WS_SSQ = 27 * MiB;
constexpr size_t WS_XN2 = 32 * MiB;
constexpr size_t WS_XN0 = 161 * MiB;
constexpr size_t WS_PROJ = 290 * MiB;
constexpr size_t WS_MIX = 581 * MiB;
constexpr size_t WS_HID = 161 * MiB;
constexpr size_t WS_SLAB = 678 * MiB;
constexpr size_t WS_END = 710 * MiB;
constexpr int DN_KSPLIT = 16;
static_assert(WS_SSQ + (size_t)MTOT * 16 * 4 <= WS_XN2 && WS_XN2 + (size_t)MTOT * D * 2 <= WS_XN0 && WS_XN0 + (size_t)MTOT * D * 2 <= WS_PROJ && WS_PROJ + (size_t)MTOT * NIN * 2 <= WS_MIX && WS_MIX + (size_t)MTOT * D * 2 <= WS_END && WS_HID + (size_t)MTOT * FF * 2 <= WS_END, "ws map");

constexpr int NWAVES = 8, NTHREADS = 512;
constexpr int LDS_BYTES = 147456;
constexpr int LDSCTL_OFF = 131072;

#define LAS __attribute__((address_space(3)))
typedef unsigned short bf16;
typedef unsigned v4u __attribute__((ext_vector_type(4)));
typedef float f32x4 __attribute__((ext_vector_type(4)));

__device__ __forceinline__ unsigned f2bf(float f) { unsigned u = __builtin_bit_cast(unsigned, f); return (u + 0x7fffu + ((u >> 16) & 1u)) >> 16; }
__device__ __forceinline__ unsigned pk2(float lo, float hi) { return f2bf(lo) | (f2bf(hi) << 16); }
__device__ __forceinline__ float bflo(unsigned w) { return __builtin_bit_cast(float, w << 16); }
__device__ __forceinline__ float bfhi(unsigned w) { return __builtin_bit_cast(float, w & 0xffff0000u); }
__device__ __forceinline__ float wave_sum(float v) {
#pragma unroll
    for (int o = 1; o < 64; o <<= 1) v += __shfl_xor(v, o);
    return v;
}

#define XB_TMO      128
#define XB_XCNT(j)  (256  + 64 * (j))
#define XB_XSUB(j)  (1280 + 64 * (j))
#define XB_XGEN(j)  (2304 + 64 * (j))
#define XB_TOP      3328
#define XB_TOPGEN   3392
#define XCD_BAR_WORDS 3456
#define XB_SPIN_CAP (1u << 18)

__device__ __forceinline__ unsigned xb_ld(unsigned* p)              { return __hip_atomic_load(p, __ATOMIC_RELAXED, __HIP_MEMORY_SCOPE_AGENT); }
__device__ __forceinline__ unsigned xb_add(unsigned* p, unsigned v) { return __hip_atomic_fetch_add(p, v, __ATOMIC_RELAXED, __HIP_MEMORY_SCOPE_AGENT); }
__device__ __forceinline__ unsigned xb_xcc_id() { return (unsigned)__builtin_amdgcn_s_getreg((3 << 11) | 20) & 0xFu; }
#define XB_SPIN(cond, bar) do { unsigned _sp = 0; while (cond) { __builtin_amdgcn_s_sleep(1); \
    if ((++_sp & 255u) == 0u) { if (xb_ld(&(bar)[XB_TMO])) break; if (_sp > XB_SPIN_CAP) { atomicAdd(&(bar)[XB_TMO], 1u); break; } } } } while (0)

struct XcdBarrier {
    unsigned* bar; unsigned x;
    volatile LAS unsigned* st;
};

__device__ __forceinline__ XcdBarrier xcd_barrier_post(unsigned* bar, volatile LAS unsigned* st) {
    XcdBarrier b; b.bar = bar; b.x = xb_xcc_id(); b.st = st;
    if (threadIdx.x == 0) (void)xb_add(&bar[XB_XCNT(b.x)], 1u);
    return b;
}
__device__ __forceinline__ void xcd_barrier_complete(unsigned* bar, unsigned x, unsigned& nloc, unsigned& nx) {
    const unsigned G = gridDim.x * gridDim.y * gridDim.z;
    unsigned sum, cnt, mine, sp = 0u;
    for (;;) {
        sum = 0u; cnt = 0u; mine = 0u;
#pragma unroll
        for (unsigned j = 0; j < 16; ++j) { const unsigned c = xb_ld(&bar[XB_XCNT(j)]); sum += c; cnt += (c > 0u) ? 1u : 0u; mine = (j == x) ? c : mine; }
        if (sum == G) break;
        __builtin_amdgcn_s_sleep(1);
        if ((++sp & 255u) == 0u) { if (xb_ld(&bar[XB_TMO])) break; if (sp > XB_SPIN_CAP) { atomicAdd(&bar[XB_TMO], 1u); break; } }
    }
    nloc = mine > 0u ? mine : 1u; nx = cnt > 0u ? cnt : 1u;
}

__device__ __forceinline__ void xcd_barrier(const XcdBarrier& b) {
    asm volatile("s_waitcnt vmcnt(0)" ::: "memory");
    __syncthreads();
    if (threadIdx.x == 0) {
        unsigned* bar = b.bar;
        __builtin_amdgcn_s_waitcnt(0);
        unsigned nloc = b.st[0], nx = b.st[1];
        if (nloc == 0u) { xcd_barrier_complete(bar, b.x, nloc, nx); b.st[0] = nloc; b.st[1] = nx; }
        const unsigned old = xb_add(&bar[XB_XSUB(b.x)], 1u);
        const unsigned gen = old / nloc;
        if (old + 1u == (gen + 1u) * nloc) {
            __builtin_amdgcn_fence(__ATOMIC_RELEASE, "agent");
            asm volatile("s_waitcnt vmcnt(0)" ::: "memory");
            const unsigned og = xb_add(&bar[XB_TOP], 1u);
            const unsigned tg = og / nx;
            if (og + 1u == (tg + 1u) * nx) xb_add(&bar[XB_TOPGEN], 1u);
            else XB_SPIN(xb_ld(&bar[XB_TOPGEN]) == tg, bar);
            __builtin_amdgcn_fence(__ATOMIC_ACQUIRE, "agent");
            xb_add(&bar[XB_XGEN(b.x)], 1u);
            asm volatile("s_waitcnt vmcnt(0)" ::: "memory");
        } else {
            XB_SPIN(xb_ld(&bar[XB_XGEN(b.x)]) == gen, bar);
            __builtin_amdgcn_fence(__ATOMIC_ACQUIRE, "agent");
            asm volatile("s_waitcnt vmcnt(0)" ::: "memory");
        }
    }
    __syncthreads();
}

struct Params {
    const float* in[20];
    float* out;
    unsigned char* ws;
};

__device__ __forceinline__ void p0_transpose_item(const float* W, int K, int N, bf16* WT, const float* gk, LAS float* scr, int item, int lane) {
    const int nblk = N / 32, kb = item / nblk, nb = item % nblk, k0 = 64 * kb, n0 = 32 * nb;
#pragma unroll 8
    for (int i = 0; i < 32; ++i) { const int kk = 2 * i + (lane >> 5); float v = W[(size_t)(k0 + kk) * N + n0 + (lane & 31)]; if (gk) v *= gk[k0 + kk]; scr[kk * 33 + (lane & 31)] = v; }
    asm volatile("s_waitcnt lgkmcnt(0)" ::: "memory");
    const int c = lane & 7;
#pragma unroll
    for (int j = 0; j < 4; ++j) { const int n = (lane >> 3) + 8 * j; const LAS float* s = scr + (8 * c) * 33 + n;
        v4u o; o.x = pk2(s[0 * 33], s[1 * 33]); o.y = pk2(s[2 * 33], s[3 * 33]); o.z = pk2(s[4 * 33], s[5 * 33]); o.w = pk2(s[6 * 33], s[7 * 33]);
        *(v4u*)(WT + (size_t)(n0 + n) * K + k0 + 8 * c) = o; }
    asm volatile("s_waitcnt lgkmcnt(0)" ::: "memory");
}
__device__ __forceinline__ void rms_row_to_bf16(const float* xrow, const float* g, bf16* orow, int lane) {
    const f32x4* xr = (const f32x4*)xrow + lane; const f32x4* gr = (const f32x4*)g + lane;
    f32x4 v[4]; float s = 0.f;
#pragma unroll
    for (int j = 0; j < 4; ++j) { v[j] = xr[64 * j]; s += (v[j].x * v[j].x + v[j].y * v[j].y) + (v[j].z * v[j].z + v[j].w * v[j].w); }
    const float rstd = 1.0f / sqrtf(wave_sum(s) * (1.f / D) + EPS);
    unsigned long long* o8 = (unsigned long long*)orow + lane;
#pragma unroll
    for (int j = 0; j < 4; ++j) { const f32x4 gg = gr[64 * j];
        o8[64 * j] = (unsigned long long)pk2(v[j].x * rstd * gg.x, v[j].y * rstd * gg.y) | ((unsigned long long)pk2(v[j].z * rstd * gg.z, v[j].w * rstd * gg.w) << 32); }
}

__device__ __forceinline__ int t5_bucket(int rel) {
    const int n = rel < 0 ? -rel : rel; int ret = rel > 0 ? 16 : 0;
    if (n < 8) return ret + n;
    int large = (31 - __clz(n * n)) + 2; if (large > 15) large = 15;
    return ret + large;
}


typedef float f32x16 __attribute__((ext_vector_type(16)));
typedef short bf16x8v __attribute__((ext_vector_type(8)));
typedef short v4i16_t __attribute__((ext_vector_type(4)));
template <int NQT>
__device__ __forceinline__ void attn_core(LAS unsigned char* KIMG, LAS unsigned char* VIMG, const LAS float* BREL, LAS float* SSQX, const bf16* PROJ, bf16* MIX, const float* g_attn, const float* sinks,
                                          size_t row0, int kt0, int ntiles, int metaoff, int wave, int lane) {
    asm volatile("" : "+v"(lane));
    const int h = wave, kvh = h >> 2, q = lane & 31, hh = lane >> 5;
    bf16x8v qf[NQT][4];
#pragma unroll
    for (int qt = 0; qt < NQT; ++qt)
#pragma unroll
        for (int ks = 0; ks < 4; ++ks) qf[qt][ks] = *(const bf16x8v*)(PROJ + (row0 + 32 * qt + q) * NIN + COL_Q + 64 * h + 16 * ks + 8 * hh);
    f32x16 O[NQT][2]; float m[NQT], l[NQT];
    const float sink2 = sinks[h] * LOG2E;
#pragma unroll
    for (int qt = 0; qt < NQT; ++qt) { m[qt] = sink2; l[qt] = hh == 0 ? 1.f : 0.f;
#pragma unroll
        for (int dt = 0; dt < 2; ++dt)
#pragma unroll
            for (int r = 0; r < 16; ++r) O[qt][dt][r] = 0.f; }
    const int kswz = q & 15;
    int koff[4];
#pragma unroll
    for (int ks = 0; ks < 4; ++ks) koff[ks] = q * 256 + (((kvh * 8 + ks * 2 + hh) ^ kswz) << 4);
    const int G4 = lane >> 4, i16 = lane & 15, vsw = (i16 >> 2) & 3;
    int voff[2];
#pragma unroll
    for (int dt = 0; dt < 2; ++dt) voff[dt] = (4 * (G4 >> 1) + (i16 >> 2)) * 256 + ((((kvh * 2 + dt) ^ vsw) << 6) | ((G4 & 1) * 32 + (i16 & 3) * 8));
    for (int kt = kt0; kt < ntiles; ++kt) {
        bf16x8v kf[4], vf[2][2];
#pragma unroll
        for (int ks = 0; ks < 4; ++ks) kf[ks] = *(const LAS bf16x8v*)(KIMG + kt * 8192 + koff[ks]);
#pragma unroll
        for (int dt = 0; dt < 2; ++dt)
#pragma unroll
            for (int s = 0; s < 2; ++s) {
                const v4i16_t a = __builtin_amdgcn_ds_read_tr16_b64_v4i16((LAS v4i16_t*)(VIMG + kt * 8192 + s * 4096 + voff[dt]));
                const v4i16_t bq = __builtin_amdgcn_ds_read_tr16_b64_v4i16((LAS v4i16_t*)(VIMG + kt * 8192 + s * 4096 + 2048 + voff[dt]));
                vf[dt][s] = (bf16x8v){a[0], a[1], a[2], a[3], bq[0], bq[1], bq[2], bq[3]}; }
        const bool lastt = (kt == ntiles - 1);
#pragma unroll
        for (int qt = 0; qt < NQT; ++qt) {
            f32x16 S;
#pragma unroll
            for (int r = 0; r < 16; ++r) S[r] = 0.f;
#pragma unroll
            for (int ks = 0; ks < 4; ++ks) S = __builtin_amdgcn_mfma_f32_32x32x16_bf16(kf[ks], qf[qt][ks], S, 0, 0, 0);
            const int i = 32 * qt + q;
            float tmax;
            if (!lastt) {
                const LAS float* bp = BREL + h * 256 + (32 * kt + 63 + 4 * hh - i);
#pragma unroll
                for (int r = 0; r < 16; ++r) S[r] = S[r] * C2 + bp[(r & 3) + 8 * (r >> 2)];
                tmax = S[0];
#pragma unroll
                for (int r = 1; r < 16; ++r) tmax = fmaxf(tmax, S[r]);
            } else {
#pragma unroll
                for (int r = 0; r < 8; ++r) { const int kr = (r & 3) + 8 * (r >> 2) + 4 * hh; int rel = kr - metaoff - i; rel = rel < -191 ? -191 : rel; S[r] = S[r] * C2 + BREL[h * 256 + rel + 191]; }
                tmax = S[0];
#pragma unroll
                for (int r = 1; r < 8; ++r) tmax = fmaxf(tmax, S[r]);
#pragma unroll
                for (int r = 8; r < 16; ++r) S[r] = -INFINITY;
            }
            tmax = fmaxf(tmax, __shfl_xor(tmax, 32));
            const float mn = fmaxf(m[qt], tmax), sc = __builtin_amdgcn_exp2f(m[qt] - mn); m[qt] = mn;
            float psum = 0.f;
#pragma unroll
            for (int r = 0; r < 16; ++r) { S[r] = __builtin_amdgcn_exp2f(S[r] - mn); psum += S[r]; }
            l[qt] = l[qt] * sc + psum;
#pragma unroll
            for (int dt = 0; dt < 2; ++dt)
#pragma unroll
                for (int r = 0; r < 16; ++r) O[qt][dt][r] *= sc;
            bf16x8v pf[2];
#pragma unroll
            for (int s = 0; s < 2; ++s) { v4u w; w.x = pg8::cvt_pk_bf16(S[8 * s + 0], S[8 * s + 1]); w.y = pg8::cvt_pk_bf16(S[8 * s + 2], S[8 * s + 3]); w.z = pg8::cvt_pk_bf16(S[8 * s + 4], S[8 * s + 5]); w.w = pg8::cvt_pk_bf16(S[8 * s + 6], S[8 * s + 7]);
                pf[s] = __builtin_bit_cast(bf16x8v, w); }
#pragma unroll
            for (int dt = 0; dt < 2; ++dt)
#pragma unroll
                for (int s = 0; s < 2; ++s) O[qt][dt] = __builtin_amdgcn_mfma_f32_32x32x16_bf16(vf[dt][s], pf[s], O[qt][dt], 0, 0, 0);
        }
    }
#pragma unroll
    for (int qt = 0; qt < NQT; ++qt) {
        const float lt = l[qt] + __shfl_xor(l[qt], 32), inv = 1.0f / lt; float ss = 0.f;
#pragma unroll
        for (int dt = 0; dt < 2; ++dt)
#pragma unroll
            for (int r = 0; r < 16; ++r) { O[qt][dt][r] *= inv; ss += O[qt][dt][r] * O[qt][dt][r]; }
        ss += __shfl_xor(ss, 32);
        if (hh == 0) SSQX[h * 64 + 32 * qt + q] = ss;
    }
    __syncthreads();
#pragma unroll
    for (int qt = 0; qt < NQT; ++qt) {
        float tot = 0.f;
#pragma unroll
        for (int h2 = 0; h2 < 8; ++h2) tot += SSQX[h2 * 64 + 32 * qt + q];
        const float rstd = 1.0f / sqrtf(tot * (1.f / QD) + EPS);
        bf16* mrow = MIX + (row0 + 32 * qt + q) * D + CONVD + 64 * h;
#pragma unroll
        for (int dt = 0; dt < 2; ++dt)
#pragma unroll
            for (int g4 = 0; g4 < 4; ++g4) { const int d0 = 32 * dt + 8 * g4 + 4 * hh; const f32x4 gv = *(const f32x4*)(g_attn + 64 * h + d0);
                pg8::u32x2 w; w.x = pg8::cvt_pk_bf16(O[qt][dt][4 * g4 + 0] * rstd * gv.x, O[qt][dt][4 * g4 + 1] * rstd * gv.y); w.y = pg8::cvt_pk_bf16(O[qt][dt][4 * g4 + 2] * rstd * gv.z, O[qt][dt][4 * g4 + 3] * rstd * gv.w);
                *(pg8::u32x2*)(mrow + d0) = w; }
    }
}

__global__ void __launch_bounds__(NTHREADS, 2) fwd_kernel(Params p) {
    extern __shared__ __attribute__((aligned(16))) unsigned char lds_raw[];
    LAS unsigned char* lds = (LAS unsigned char*)lds_raw;
    const int tid = threadIdx.x, lane = tid & 63, wave = __builtin_amdgcn_readfirstlane(tid >> 6);
    const int G = gridDim.x, bid = blockIdx.x;
    if (tid < 16) ((LAS unsigned*)(lds + LDSCTL_OFF))[tid] = 0u;
    __syncthreads();
    const XcdBarrier bar = xcd_barrier_post((unsigned*)(*(unsigned char* const __attribute__((address_space(4)))*)((const __attribute__((address_space(4))) unsigned char*)__builtin_amdgcn_kernarg_segment_ptr() + 168) + WS_CTL) + 1024, (volatile LAS unsigned*)(lds + LDSCTL_OFF));
#define KARGS() const __attribute__((address_space(4))) unsigned char* ka_ = (const __attribute__((address_space(4))) unsigned char*)__builtin_amdgcn_kernarg_segment_ptr(); asm volatile("" : "+s"(ka_))
#define KIN(i) (*(const float* const __attribute__((address_space(4)))*)(ka_ + 8 * (i)))
#define KOUT() (*(float* const __attribute__((address_space(4)))*)(ka_ + 160))
#define KWS() (*(unsigned char* const __attribute__((address_space(4)))*)(ka_ + 168))
    {
        KARGS(); unsigned char* ws = KWS(); float* out = KOUT();
        const float* x_prompt = KIN(0); const float* x_sample = KIN(1); const float* meta_tokens = KIN(7); const float* g_mix = KIN(8); const float* w_in = KIN(9);
        const float* w_out = KIN(15); const float* g_mlp = KIN(16); const float* w_up = KIN(17); const float* w_down = KIN(18);
        bf16* WinT = (bf16*)(ws + WS_WIN); bf16* WoutT = (bf16*)(ws + WS_WOUT); bf16* WupT = (bf16*)(ws + WS_WUP); bf16* WdnT = (bf16*)(ws + WS_WDN);
        float* METAPROJ = (float*)(ws + WS_METAPROJ); bf16* METAKV = (bf16*)(ws + WS_METAKV); bf16* XN0 = (bf16*)(ws + WS_XN0);
        if (bid < NIN / 64) {
            LAS float* xnT = (LAS float*)lds;
            LAS float* red = (LAS float*)(lds + 65536);
            for (int rr = 0; rr < 2; ++rr) { const int r = 2 * wave + rr; const f32x4* xr = (const f32x4*)(meta_tokens + (size_t)r * D) + lane; const f32x4* gr = (const f32x4*)g_mix + lane;
                f32x4 v[4]; float s = 0.f;
#pragma unroll
                for (int j = 0; j < 4; ++j) { v[j] = xr[64 * j]; s += (v[j].x * v[j].x + v[j].y * v[j].y) + (v[j].z * v[j].z + v[j].w * v[j].w); }
                const float rstd = 1.0f / sqrtf(wave_sum(s) * (1.f / D) + EPS);
#pragma unroll
                for (int j = 0; j < 4; ++j) { const f32x4 gg = gr[64 * j]; const int k = 4 * lane + 256 * j;
                    xnT[(k + 0) * 16 + r] = v[j].x * rstd * gg.x; xnT[(k + 1) * 16 + r] = v[j].y * rstd * gg.y; xnT[(k + 2) * 16 + r] = v[j].z * rstd * gg.z; xnT[(k + 3) * 16 + r] = v[j].w * rstd * gg.w; } }
            __syncthreads();
            const int n = 64 * bid + lane; float acc[16];
#pragma unroll
            for (int r = 0; r < 16; ++r) acc[r] = 0.f;
            for (int k = 128 * wave; k < 128 * wave + 128; ++k) { const float wv = w_in[(size_t)k * NIN + n]; const LAS f32x4* xs = (const LAS f32x4*)(xnT + k * 16);
#pragma unroll
                for (int q = 0; q < 4; ++q) { const f32x4 xv = xs[q]; acc[4 * q + 0] += xv.x * wv; acc[4 * q + 1] += xv.y * wv; acc[4 * q + 2] += xv.z * wv; acc[4 * q + 3] += xv.w * wv; } }
#pragma unroll
            for (int r = 0; r < 16; ++r) red[(wave * 16 + r) * 64 + lane] = acc[r];
            __syncthreads();
            for (int o = tid; o < 1024; o += NTHREADS) { const int r = o >> 6, l = o & 63; float s = 0.f;
#pragma unroll
                for (int w = 0; w < 8; ++w) s += red[(w * 16 + r) * 64 + l];
                const int nn = 64 * bid + l; METAPROJ[r * NIN + nn] = s;
                if (nn >= COL_K) { const int kc = nn - COL_K; METAKV[r * 256 + kc] = (bf16)f2bf(s);
                    float* dst = (kc < 128) ? out + O_PMK + r * 128 + kc : out + O_PMV + r * 128 + (kc - 128);
#pragma unroll
                    for (int b = 0; b < NB; ++b) dst[(size_t)b * NMETA * 128] = s; } }
            __syncthreads();
        }
        LAS float* scr = (LAS float*)(lds + wave * 16384);
        const int gw = bid * NWAVES + wave, NGW = G * NWAVES;
        constexpr int I_IN = (D / 64) * (NIN / 32), I_OUT = (D / 64) * (D / 32), I_UP = (D / 64) * (FF / 32), I_DN = (FF / 64) * (D / 32);
        constexpr int NITEMS = I_IN + I_OUT + I_UP + I_DN;
        for (int it = gw; it < NITEMS; it += NGW) {
            int r = it;
            if (r < I_IN) { p0_transpose_item(w_in, D, NIN, WinT, nullptr, scr, r, lane); continue; } r -= I_IN;
            if (r < I_OUT) { p0_transpose_item(w_out, D, D, WoutT, nullptr, scr, r, lane); continue; } r -= I_OUT;
            if (r < I_UP) { p0_transpose_item(w_up, D, FF, WupT, g_mlp, scr, r, lane); continue; } r -= I_UP;
            p0_transpose_item(w_down, FF, D, WdnT, nullptr, scr, r, lane);
        }
        for (int m = gw; m < MTOT; m += NGW) {
            const float* xrow = (m < NPROMPT) ? x_prompt + (size_t)m * D : x_sample + (size_t)(m - NPROMPT) * D;
            rms_row_to_bf16(xrow, g_mix, XN0 + (size_t)m * D, lane);
        }
    }
    xcd_barrier(bar);

    {
        KARGS(); unsigned char* ws = KWS(); bf16* WinT = (bf16*)(ws + WS_WIN); bf16* XN0 = (bf16*)(ws + WS_XN0); bf16* PROJ = (bf16*)(ws + WS_PROJ);
        pg8::Gemm g{XN0, WinT, MTOT, NIN, D}; typedef pg8::PhaseOrder<NPROMPT / 256, NSAMP / 256, NIN, D, 1> Ord; Ord S; S.init(G, bid);
        pg8::EpiProj E{PROJ, NIN};
        pg8::gemm_phase<pg8::EpiProj, Ord, true, true>(lds, g, S, E);
    }
    xcd_barrier(bar);

    {
        KARGS(); unsigned char* ws = KWS(); float* out = KOUT();
        const float* cache_k = KIN(2); const float* cache_v = KIN(3); const float* cache_mk = KIN(4); const float* cache_mv = KIN(5); const float* state_conv = KIN(6);
        const float* conv_w = KIN(10); const float* sinks = KIN(11); const float* rel_table = KIN(12); const float* g_conv = KIN(13); const float* g_attn = KIN(14);
        const float* METAPROJ = (const float*)(ws + WS_METAPROJ); const bf16* METAKV = (const bf16*)(ws + WS_METAKV); const bf16* PROJ = (const bf16*)(ws + WS_PROJ); bf16* MIX = (bf16*)(ws + WS_MIX);
        LAS unsigned char* KIMG = lds;
        LAS unsigned char* VIMG = lds + 57344;
        LAS float* BREL = (LAS float*)(lds + 114688);
        LAS float* SSQX = (LAS float*)(lds + 114688 + 8192);
        for (int o = tid; o < 8 * 256; o += NTHREADS) { const int h = o >> 8, idx = o & 255; const int rel = idx - 191; BREL[o] = (idx < 255) ? rel_table[t5_bucket(rel) * 8 + h] * LOG2E : 0.f; }
        __syncthreads();
        const int NUNITS = NB * (SEQ / 64) + SB;
        for (int u = bid; u < NUNITS; u += G) {
            const bool isA = u < NB * (SEQ / 64);
            const int b = isA ? u / (SEQ / 64) : u - NB * (SEQ / 64);
            const int c = isA ? u % (SEQ / 64) : 0;
            const int ntok = isA ? 64 : 32, nwin = isA ? 192 : 160, nk = nwin + 16, ntiles = isA ? 7 : 6;
            const size_t row0 = isA ? (size_t)b * SEQ + 64 * c : (size_t)NPROMPT + 32 * b;
            for (int ch = tid; ch < ntiles * 32 * 32; ch += NTHREADS) { const int j = ch >> 5, cc = ch & 31;
                v4u val = (v4u){0u, 0u, 0u, 0u};
                if (j < nk) {
                    if (isA) {
                        if (j < 192) { const int tk = 64 * (c - 2) + j; if (tk >= 0) val = *(const v4u*)(PROJ + ((size_t)b * SEQ + tk) * NIN + COL_K + 8 * cc); }
                        else val = *(const v4u*)(METAKV + (j - 192) * 256 + 8 * cc);
                    } else {
                        const float* src = nullptr;
                        if (j < 128) src = (cc < 16 ? cache_k : cache_v) + ((size_t)b * 128 + j) * 128 + 8 * (cc & 15);
                        else if (j >= 160) src = (cc < 16 ? cache_mk : cache_mv) + ((size_t)b * 16 + (j - 160)) * 128 + 8 * (cc & 15);
                        if (src) { const f32x4 a = *(const f32x4*)src, bb = *(const f32x4*)(src + 4); val.x = pk2(a.x, a.y); val.y = pk2(a.z, a.w); val.z = pk2(bb.x, bb.y); val.w = pk2(bb.z, bb.w); }
                        else val = *(const v4u*)(PROJ + (row0 + (j - 128)) * NIN + COL_K + 8 * cc);
                    }
                }
                if (cc < 16) *(LAS v4u*)(KIMG + j * 256 + ((cc ^ (j & 15)) << 4)) = val;
                else { const int c2 = cc - 16; *(LAS v4u*)(VIMG + j * 256 + (((((c2 >> 2) ^ (j & 3)) << 2) | (c2 & 3)) << 4)) = val; } }
            __syncthreads();
            if (isA) { if (c >= 126) { for (int o = tid; o < 64 * 256; o += NTHREADS) { const int i = o >> 8, col = o & 255; const float v = __builtin_bit_cast(float, (unsigned)PROJ[(row0 + i) * NIN + COL_K + col] << 16); const int t = 64 * (c - 126) + i;
                    if (col < 128) out[O_PK + ((size_t)b * 128 + t) * 128 + col] = v; else out[O_PV + ((size_t)b * 128 + t) * 128 + (col - 128)] = v; } } }
            else { for (int o = tid; o < 32 * 256; o += NTHREADS) { const int i = o >> 8, col = o & 255; const float v = __builtin_bit_cast(float, (unsigned)PROJ[(row0 + i) * NIN + COL_K + col] << 16);
                    if (col < 128) out[O_SK + ((size_t)b * 32 + i) * 128 + col] = v; else out[O_SV + ((size_t)b * 32 + i) * 128 + (col - 128)] = v; } }
            if (isA) attn_core<2>(KIMG, VIMG, BREL, SSQX, PROJ, MIX, g_attn, sinks, row0, (c >= 2 ? 0 : 4 - 2 * c), 7, 16 + 64 * c, wave, lane);
            else     attn_core<1>(KIMG, VIMG, BREL, SSQX, PROJ, MIX, g_attn, sinks, row0, 0, 6, 16 + 4096, wave, lane);
            {
                const int tpw = ntok / 8, ch = 8 * lane;
                float w0[8], w1[8], w2[8], gc[8];
#pragma unroll
                for (int e = 0; e < 8; ++e) { w0[e] = conv_w[ch + e]; w1[e] = conv_w[CONVD + ch + e]; w2[e] = conv_w[2 * CONVD + ch + e]; gc[e] = g_conv[ch + e]; }
                float ua[8] = {0.f, 0.f, 0.f, 0.f, 0.f, 0.f, 0.f, 0.f}, ub[8] = {0.f, 0.f, 0.f, 0.f, 0.f, 0.f, 0.f, 0.f}, uc[8];
                for (int tt = -2; tt < tpw; ++tt) {
                    const int t = tpw * wave + tt;
                    const int tg = isA ? 64 * c + t : t;
                    if (tg >= 0) { const bf16* pr = PROJ + (isA ? (size_t)b * SEQ + tg : (size_t)NPROMPT + 32 * b + tg) * NIN;
                        const v4u cw = *(const v4u*)(pr + COL_C + ch), uw = *(const v4u*)(pr + COL_U + ch);
                        uc[0] = bflo(cw.x) * bflo(uw.x); uc[1] = bfhi(cw.x) * bfhi(uw.x); uc[2] = bflo(cw.y) * bflo(uw.y); uc[3] = bfhi(cw.y) * bfhi(uw.y);
                        uc[4] = bflo(cw.z) * bflo(uw.z); uc[5] = bfhi(cw.z) * bfhi(uw.z); uc[6] = bflo(cw.w) * bflo(uw.w); uc[7] = bfhi(cw.w) * bfhi(uw.w); }
                    else if (isA) { const float* mp = METAPROJ + (size_t)(16 + tg) * NIN;
#pragma unroll
                        for (int e = 0; e < 8; ++e) uc[e] = mp[COL_C + ch + e] * mp[COL_U + ch + e]; }
                    else { const float* sp = state_conv + ((size_t)b * 2 + (2 + tg)) * CONVD + ch;
#pragma unroll
                        for (int e = 0; e < 8; ++e) uc[e] = sp[e]; }
                    if (tt >= 0) {
                        const size_t row = row0 + t; const v4u bw = *(const v4u*)(PROJ + row * NIN + COL_B + ch);
                        float bv[8] = {bflo(bw.x), bfhi(bw.x), bflo(bw.y), bfhi(bw.y), bflo(bw.z), bfhi(bw.z), bflo(bw.w), bfhi(bw.w)};
                        float y[8]; float ss = 0.f;
#pragma unroll
                        for (int e = 0; e < 8; ++e) { y[e] = bv[e] * (w0[e] * ua[e] + w1[e] * ub[e] + w2[e] * uc[e]); ss += y[e] * y[e]; }
                        const float rstd = 1.0f / sqrtf(wave_sum(ss) * (1.f / CONVD) + EPS);
                        v4u w; w.x = pk2(y[0] * rstd * gc[0], y[1] * rstd * gc[1]); w.y = pk2(y[2] * rstd * gc[2], y[3] * rstd * gc[3]); w.z = pk2(y[4] * rstd * gc[4], y[5] * rstd * gc[5]); w.w = pk2(y[6] * rstd * gc[6], y[7] * rstd * gc[7]);
                        *(v4u*)(MIX + row * D + ch) = w;
                        const int last = isA ? (c == SEQ / 64 - 1 ? 64 : 1 << 30) : 32;
                        if (t >= last - 2) { float* dst = (isA ? out + O_PC + ((size_t)b * 2 + (t - (last - 2))) * CONVD : out + O_SC + ((size_t)b * 2 + (t - (last - 2))) * CONVD) + ch;
#pragma unroll
                            for (int e = 0; e < 8; ++e) dst[e] = uc[e]; }
                    }
#pragma unroll
                    for (int e = 0; e < 8; ++e) { ua[e] = ub[e]; ub[e] = uc[e]; }
                }
            }
            __syncthreads();
        }
    }
    xcd_barrier(bar);

    {
        KARGS(); unsigned char* ws = KWS(); float* out = KOUT(); const float* x_prompt = KIN(0); const float* x_sample = KIN(1);
        bf16* WoutT = (bf16*)(ws + WS_WOUT); bf16* MIX = (bf16*)(ws + WS_MIX); bf16* XN2 = (bf16*)(ws + WS_XN2); float* SSQ = (float*)(ws + WS_SSQ);
        pg8::Gemm g{MIX, WoutT, MTOT, D, D}; typedef pg8::PhaseOrder<NPROMPT / 256, NSAMP / 256, D, D, 1> Ord; Ord S; S.init(G, bid);
        pg8::EpiOut E{x_prompt, x_sample, out, XN2, SSQ, NPROMPT};
        pg8::gemm_phase<pg8::EpiOut, Ord, true, true>(lds, g, S, E);
    }
    xcd_barrier(bar);

    {
        KARGS(); unsigned char* ws = KWS(); bf16* WupT = (bf16*)(ws + WS_WUP); bf16* XN2 = (bf16*)(ws + WS_XN2); float* SSQ = (float*)(ws + WS_SSQ); bf16* HID = (bf16*)(ws + WS_HID);
        pg8::Gemm g{XN2, WupT, MTOT, FF, D}; typedef pg8::PhaseOrder<NPROMPT / 256, NSAMP / 256, FF, D, 1> Ord; Ord S; S.init(G, bid);
        pg8::EpiUp E{HID, FF, SSQ};
        pg8::gemm_phase<pg8::EpiUp, Ord, true, true>(lds, g, S, E);
    }
    xcd_barrier(bar);

    {
        KARGS(); unsigned char* ws = KWS(); float* out = KOUT(); bf16* WdnT = (bf16*)(ws + WS_WDN); bf16* HID = (bf16*)(ws + WS_HID);
        pg8::Gemm g{HID, WdnT, MTOT, D, FF}; typedef pg8::PhaseOrder<NPROMPT / 256, NSAMP / 256, D, FF, DN_KSPLIT> Ord; Ord S; S.init(G, bid);
        pg8::EpiDown E{out, (float*)(ws + WS_SLAB), NPROMPT / 256, NSAMP};
        pg8::gemm_phase<pg8::EpiDown, Ord, true, true>(lds, g, S, E);
    }
    xcd_barrier(bar);

    {
        KARGS(); unsigned char* ws = KWS(); float* out = KOUT(); const float* g_final = KIN(19);
        const int gw = bid * NWAVES + wave, NGW = G * NWAVES;
        for (int m = gw; m < MTOT; m += NGW) {
            f32x4* xr = (f32x4*)(out + (size_t)m * D) + lane; const f32x4* gr = (const f32x4*)g_final + lane;
            f32x4 v[4]; float s = 0.f;
#pragma unroll
            for (int j = 0; j < 4; ++j) v[j] = xr[64 * j];
            if (m >= NPROMPT) {
                const f32x4* sl = (const f32x4*)((const float*)(ws + WS_SLAB) + (size_t)(m - NPROMPT) * D) + lane;
                for (int ks = 0; ks < DN_KSPLIT; ++ks, sl += (size_t)NSAMP * D / 4) {
#pragma unroll
                    for (int j = 0; j < 4; ++j) v[j] += sl[64 * j]; } }
#pragma unroll
            for (int j = 0; j < 4; ++j) s += (v[j].x * v[j].x + v[j].y * v[j].y) + (v[j].z * v[j].z + v[j].w * v[j].w);
            const float rstd = 1.0f / sqrtf(wave_sum(s) * (1.f / D) + EPS);
#pragma unroll
            for (int j = 0; j < 4; ++j) { const f32x4 gg = gr[64 * j]; xr[64 * j] = v[j] * rstd * gg; }
        }
    }
}

extern "C" void kernel_launch(void* const* d_in, const int* in_sizes, int n_in, void* d_out, int out_size, void* d_ws, size_t ws_size, hipStream_t stream) {
    static int grid = 0;
    if (grid == 0) {
        if (n_in != 20 || in_sizes[0] != NPROMPT * D || out_size != (int)O_END || ws_size < WS_END) { fprintf(stderr, "kernel_launch: unexpected shapes (n_in %d, in0 %d, out %d, ws %zu)\n", n_in, n_in > 0 ? in_sizes[0] : -1, out_size, ws_size); grid = -1; return; }
        int dev = 0, cus = 0, per_cu = 0;
        if (hipGetDevice(&dev) != hipSuccess || hipDeviceGetAttribute(&cus, hipDeviceAttributeMultiprocessorCount, dev) != hipSuccess) { grid = -1; return; }
        if (hipFuncSetAttribute((const void*)fwd_kernel, hipFuncAttributeMaxDynamicSharedMemorySize, LDS_BYTES) != hipSuccess) { fprintf(stderr, "kernel_launch: hipFuncSetAttribute failed\n"); grid = -1; return; }
        if (hipOccupancyMaxActiveBlocksPerMultiprocessor(&per_cu, (const void*)fwd_kernel, NTHREADS, LDS_BYTES) != hipSuccess || per_cu < 1) { fprintf(stderr, "kernel_launch: occupancy query says %d blocks per CU\n", per_cu); (void)hipGetLastError(); grid = -1; return; }
        grid = cus;
    }
    if (grid < 0) return;
    Params p{};
    for (int i = 0; i < 20; ++i) p.in[i] = (const float*)d_in[i];
    p.out = (float*)d_out; p.ws = (unsigned char*)d_ws;
    if (hipMemsetAsync((char*)d_ws + WS_CTL, 0, CTL_ZERO_BYTES, stream) != hipSuccess) { fprintf(stderr, "kernel_launch: memset failed\n"); return; }
    hipLaunchKernelGGL(fwd_kernel, dim3(grid), dim3(NTHREADS), LDS_BYTES, stream, p);
    const hipError_t e = hipPeekAtLastError();
    if (e != hipSuccess) fprintf(stderr, "kernel_launch: launch failed: %s (grid %d)\n", hipGetErrorString(e), grid);
}
```

```cpp
#include <hip/hip_runtime.h>
#include <cstdio>
#include <cstdint>
namespace pg8 {
#define PG8_LAS __attribute__((address_space(3)))
typedef unsigned short bf16_t;
typedef short bf16x8 __attribute__((ext_vector_type(8)));
typedef float f32x4 __attribute__((ext_vector_type(4)));
typedef unsigned u32x4 __attribute__((ext_vector_type(4)));
constexpr int BM = 256, BK = 64, HALF = 128, HTB = HALF * BK * 2  , STAGE_BYTES = 8 * HTB, NXCD = 8, WGM = 8;

__host__ __device__ __forceinline__ int lds_byte(int r, int c) { const int st = (r >> 4) * 2 + (c >> 5), rr = r & 15, cc = c & 31, ob = rr * 64 + cc * 2; return st * 1024 + (ob ^ (((ob >> 9) & 1) << 5)); }
__host__ __device__ __forceinline__ void stage_rc(int b, int& R, int& C) { const int st = b / 1024, sb = b % 1024, swz = sb ^ (((sb >> 9) & 1) << 5); R = (st >> 1) * 16 + swz / 64; C = (st & 1) * 32 + (swz % 64) / 2; }
__host__ __device__ __forceinline__ int perm32(int rho) { const int n = rho >> 4, i = rho & 15; return 8 * (i >> 2) + 4 * n + (i & 3); }

struct Unit { int pm, pn, kofs, nt, ks; };
struct Gemm { const bf16_t* A; const bf16_t* Bt; int M, N, K; };

struct StaticOrder {
    int nM, nN, nwg, G, c;
    __host__ __device__ __forceinline__ void init(int M, int N, int G_, int c_) { nM = M / BM; nN = N / BM; nwg = nM * nN; G = G_; c = c_; }
    __host__ __device__ __forceinline__ bool next(int i, Unit& u) const {
        const long L = (long)i * G + c; if (L >= nwg) return false;
        int wgid = (int)L; { const int q = nwg / NXCD, r = nwg % NXCD, xcd = wgid % NXCD, off = wgid / NXCD; wgid = (xcd < r ? xcd * (q + 1) : r * (q + 1) + (xcd - r) * q) + off; }
        const int nig = WGM * nN, gid = wgid / nig, fm = gid * WGM, gsz = (nM - fm) < WGM ? (nM - fm) : WGM;
        u.pm = fm + ((wgid % nig) % gsz); u.pn = (wgid % nig) / gsz; return true;
    }
    __device__ __forceinline__ void a_ready(const Unit&) const {}
    __device__ __forceinline__ void done(const Unit&) const {}
};

template <int NMP, int NMS, int N, int K, int KSPLIT>
struct PhaseOrder {
    static constexpr int nN = N / BM, nwg = NMP * nN, ntfull = K / BK, nextra = NMS * nN * KSPLIT;
    int G, c;
    __device__ __forceinline__ void init(int G_, int c_) { G = G_; c = c_; }
    __device__ __forceinline__ Unit get(int i) const {
        const int L = i * G + c; Unit u;
        if (L < nwg) {
            int wgid = L; { constexpr int q = nwg / NXCD, r = nwg % NXCD; const int xcd = wgid % NXCD, off = wgid / NXCD; wgid = (xcd < r ? xcd * (q + 1) : r * (q + 1) + (xcd - r) * q) + off; }
            constexpr int nig = WGM * nN; const int gid = wgid / nig, fm = gid * WGM, gsz = (NMP - fm) < WGM ? (NMP - fm) : WGM;
            u.pm = fm + ((wgid % nig) % gsz); u.pn = (wgid % nig) / gsz; u.kofs = 0; u.nt = ntfull; u.ks = 0;
        } else {
            const int e = L - nwg;
            u.ks = e % KSPLIT; u.pn = (e / KSPLIT) % nN; u.pm = NMP + e / (KSPLIT * nN); u.nt = (e < nextra) ? ntfull / KSPLIT : 0; u.kofs = u.ks * (ntfull / KSPLIT) * BK;
        }
        return u;
    }
    __device__ __forceinline__ void a_ready(const Unit&) const {}
    __device__ __forceinline__ void done(const Unit&) const {}
};
__device__ __forceinline__ unsigned cvt_pk_bf16(float lo, float hi) { unsigned r; asm volatile("v_cvt_pk_bf16_f32 %0, %1, %2" : "=v"(r) : "v"(lo), "v"(hi)); return r; }
typedef unsigned u32x2 __attribute__((ext_vector_type(2)));
constexpr float RMS_EPS = 1e-6f;

struct EpiProj {
    static constexpr bool PERM = true, AFTER_DRAIN = false;
    bf16_t* O; int ldc;
    __device__ __forceinline__ void operator()(const f32x4 (&acc)[2][2][4][2], const Unit& u, int wr, int wc, int fr, int fq) const {
        const int row0 = u.pm * BM + wr * 64 + fr, col0 = u.pn * BM + wc * 32 + 8 * fq;
#pragma unroll
        for (int ai = 0; ai < 2; ++ai)
#pragma unroll
            for (int m = 0; m < 4; ++m) { bf16_t* rowp = O + (size_t)(row0 + ai * HALF + m * 16) * ldc + col0;
#pragma unroll
                for (int bj = 0; bj < 2; ++bj) { const f32x4 v0 = acc[ai][bj][m][0], v1 = acc[ai][bj][m][1];
                    u32x4 w; w.x = cvt_pk_bf16(v0[0], v0[1]); w.y = cvt_pk_bf16(v0[2], v0[3]); w.z = cvt_pk_bf16(v1[0], v1[1]); w.w = cvt_pk_bf16(v1[2], v1[3]);
                    *(u32x4*)(rowp + bj * HALF) = w; } }
    }
};
struct EpiUp {
    static constexpr bool PERM = true, AFTER_DRAIN = false;
    bf16_t* O; int ldc;
    __device__ __forceinline__ void operator()(const f32x4 (&acc)[2][2][4][2], const Unit& u, int wr, int wc, int fr, int fq) const {
        const int row0 = u.pm * BM + wr * 64 + fr, col0 = u.pn * BM + wc * 32 + 8 * fq;
#pragma unroll
        for (int ai = 0; ai < 2; ++ai)
#pragma unroll
            for (int m = 0; m < 4; ++m) { bf16_t* rowp = O + (size_t)(row0 + ai * HALF + m * 16) * ldc + col0;
#pragma unroll
                for (int bj = 0; bj < 2; ++bj) { f32x4 v0 = acc[ai][bj][m][0], v1 = acc[ai][bj][m][1];
#pragma unroll
                    for (int e = 0; e < 4; ++e) { v0[e] = fmaxf(v0[e], 0.f); v0[e] *= v0[e]; v1[e] = fmaxf(v1[e], 0.f); v1[e] *= v1[e]; }
                    u32x4 w; w.x = cvt_pk_bf16(v0[0], v0[1]); w.y = cvt_pk_bf16(v0[2], v0[3]); w.z = cvt_pk_bf16(v1[0], v1[1]); w.w = cvt_pk_bf16(v1[2], v1[3]);
                    *(u32x4*)(rowp + bj * HALF) = w; } }
    }
};
struct EpiOut {
    static constexpr bool PERM = false, AFTER_DRAIN = false;
    const float* xp; const float* xs; bf16_t* xn; float* ssq; int nprompt;
    __device__ __forceinline__ void operator()(const f32x4 (&acc)[2][2][4][2], const Unit& u, int wr, int wc, int fr, int fq) const {
        const int col0 = u.pn * BM + wc * 32 + 4 * fq;
#pragma unroll
        for (int ai = 0; ai < 2; ++ai)
#pragma unroll
            for (int m = 0; m < 4; ++m) { const int row = u.pm * BM + ai * HALF + wr * 64 + m * 16 + fr;
                const float* base = (row < nprompt) ? xp + (size_t)row * 1024 : xs + (size_t)(row - nprompt) * 1024;
                float q = 0.f;
#pragma unroll
                for (int bj = 0; bj < 2; ++bj)
#pragma unroll
                    for (int n = 0; n < 2; ++n) { const int c = col0 + bj * HALF + n * 16; const f32x4 h = *(const f32x4*)(base + c) + acc[ai][bj][m][n];
                        u32x2 w; w.x = cvt_pk_bf16(h[0], h[1]); w.y = cvt_pk_bf16(h[2], h[3]); *(u32x2*)(xn + (size_t)row * 1024 + c) = w;
                        q += (h[0] * h[0] + h[1] * h[1]) + (h[2] * h[2] + h[3] * h[3]); }
                q += __shfl_xor(q, 16); q += __shfl_xor(q, 32);
                if (fq == 0) ssq[(size_t)row * 16 + u.pn * 4 + wc] = q; }
    }
};
struct EpiDown {
    static constexpr bool PERM = true, AFTER_DRAIN = false;
    bf16_t* O; float* slab; int nMp; int nsrows;
    __device__ __forceinline__ void operator()(const f32x4 (&acc)[2][2][4][2], const Unit& u, int wr, int wc, int fr, int fq) const {
        const int col0 = u.pn * BM + wc * 32 + 8 * fq;
        if (u.pm < nMp) {
            const int row0 = u.pm * BM + wr * 64 + fr;
#pragma unroll
            for (int ai = 0; ai < 2; ++ai)
#pragma unroll
                for (int m = 0; m < 4; ++m) { bf16_t* rowp = O + (size_t)(row0 + ai * HALF + m * 16) * 1024 + col0;
#pragma unroll
                    for (int bj = 0; bj < 2; ++bj) { const f32x4 v0 = acc[ai][bj][m][0], v1 = acc[ai][bj][m][1];
                        u32x4 w; w.x = cvt_pk_bf16(v0[0], v0[1]); w.y = cvt_pk_bf16(v0[2], v0[3]); w.z = cvt_pk_bf16(v1[0], v1[1]); w.w = cvt_pk_bf16(v1[2], v1[3]);
                        *(u32x4*)(rowp + bj * HALF) = w; } }
        } else {
            float* sl = slab + (size_t)u.ks * nsrows * 1024;
#pragma unroll
            for (int ai = 0; ai < 2; ++ai)
#pragma unroll
                for (int m = 0; m < 4; ++m) { const int row = (u.pm - nMp) * BM + ai * HALF + wr * 64 + m * 16 + fr; float* rowp = sl + (size_t)row * 1024 + col0;
#pragma unroll
                    for (int bj = 0; bj < 2; ++bj)
#pragma unroll
                        for (int n = 0; n < 2; ++n) *(f32x4*)(rowp + bj * HALF + n * 4) = acc[ai][bj][m][n]; }
        }
    }
};

template <class Epi, class Sched, bool ALIGN_EPI = false, bool SP2 = false>
__device__ __forceinline__ void gemm_phase(PG8_LAS unsigned char* lds, const Gemm g, const Sched& S, const Epi& E) {
    int tid_l = threadIdx.x; asm volatile("" : "+v"(tid_l));
    const int tid = tid_l, wid = __builtin_amdgcn_readfirstlane(tid >> 6), lane = tid & 63, wr = wid >> 2, wc = wid & 3, fr = lane & 15, fq = lane >> 4;
    const int K = g.K;
    unsigned voffA[2], voffB[2];
#pragma unroll
    for (int i = 0; i < 2; ++i) { int R, C; stage_rc(tid * 16 + i * 8192, R, C); const int Rb = Epi::PERM ? ((R & ~31) + perm32(R & 31)) : R;
        voffA[i] = (unsigned)(R * K + C) * 2u; voffB[i] = (unsigned)(Rb * K + C) * 2u; }
    const size_t kstep = (size_t)(BK * 2);
    const size_t hstep = (size_t)HALF * K * 2;
    const size_t tstep = 2 * hstep;
    const unsigned ldsw = (unsigned)wid * 1024u;
    const int aoff = lds_byte(wr * 64 + fr, fq * 8), boff = lds_byte(wc * 32 + fr, fq * 8);
#define PG8_SA(b, h) (((b) * 2 + (h)) * HTB)
#define PG8_SB(b, h) ((4 + (b) * 2 + (h)) * HTB)
#define PG8_STAGE(bufoff, gbase, voff) do { _Pragma("unroll") for (int _i = 0; _i < 2; ++_i) \
        __builtin_amdgcn_global_load_lds((const unsigned*)((const char*)(gbase) + (voff)[_i]), (PG8_LAS unsigned*)(lds + (bufoff) + ldsw + _i * 8192), 16, 0, 0); } while (0)
#define PG8_LDA(dst, b, h) do { _Pragma("unroll") for (int m = 0; m < 4; ++m) _Pragma("unroll") for (int k = 0; k < 2; ++k) dst[m][k] = *(const PG8_LAS bf16x8*)(lds + PG8_SA(b, h) + aoff + m * 2048 + k * 1024); } while (0)
#define PG8_LDB(dst, b, h) do { _Pragma("unroll") for (int n = 0; n < 2; ++n) _Pragma("unroll") for (int k = 0; k < 2; ++k) dst[n][k] = *(const PG8_LAS bf16x8*)(lds + PG8_SB(b, h) + boff + n * 2048 + k * 1024); } while (0)
#define PG8_MMA(ai, bj, At, Bt) do { __builtin_amdgcn_s_setprio(1); _Pragma("unroll") for (int m = 0; m < 4; ++m) _Pragma("unroll") for (int n = 0; n < 2; ++n) _Pragma("unroll") for (int k = 0; k < 2; ++k) \
        acc[ai][bj][m][n] = __builtin_amdgcn_mfma_f32_16x16x32_bf16(Bt[n][k], At[m][k], acc[ai][bj][m][n], 0, 0, 0); __builtin_amdgcn_s_setprio(0); } while (0)
#define PG8_WAIT_V(n) asm volatile("s_waitcnt vmcnt(" #n ")" ::: "memory")
#define PG8_WAIT_L(n) asm volatile("s_waitcnt lgkmcnt(" #n ")" ::: "memory")
#define PG8_BAR __builtin_amdgcn_s_barrier()
#define PG8_SCHED __builtin_amdgcn_sched_barrier(0)
    Unit cur = S.get(0), nxt; int ui = 0;
    if (cur.nt == 0) return;
    f32x4 acc[2][2][4][2];
#pragma unroll
    for (int a = 0; a < 2; ++a)
#pragma unroll
        for (int b = 0; b < 2; ++b)
#pragma unroll
            for (int m = 0; m < 4; ++m)
#pragma unroll
                for (int n = 0; n < 2; ++n) acc[a][b][m][n] = (f32x4){0.f, 0.f, 0.f, 0.f};
    bf16x8 At[4][2], B0[2][2], B1[2][2];
    const char* cA = (const char*)g.A + (size_t)cur.pm * tstep + (size_t)cur.kofs * 2; const char* cB = (const char*)g.Bt + (size_t)cur.pn * tstep + (size_t)cur.kofs * 2;
    S.a_ready(cur);
    if constexpr (SP2) {
        PG8_STAGE(PG8_SB(0, 0), cB, voffB); PG8_STAGE(PG8_SB(0, 1), cB + hstep, voffB); PG8_STAGE(PG8_SA(0, 0), cA, voffA); PG8_STAGE(PG8_SA(0, 1), cA + hstep, voffA);
        if (wr == 1) PG8_BAR;
        PG8_WAIT_V(2); PG8_BAR;
        PG8_STAGE(PG8_SB(1, 0), cB + kstep, voffB); PG8_STAGE(PG8_SA(1, 0), cA + kstep, voffA); PG8_STAGE(PG8_SB(1, 1), cB + hstep + kstep, voffB);
        PG8_WAIT_V(6); PG8_BAR;
    } else {
        PG8_STAGE(PG8_SB(0, 0), cB, voffB); PG8_STAGE(PG8_SA(0, 0), cA, voffA); PG8_STAGE(PG8_SB(0, 1), cB + hstep, voffB); PG8_STAGE(PG8_SA(0, 1), cA + hstep, voffA);
        if (wr == 1) PG8_BAR;
        PG8_WAIT_V(4); PG8_BAR;
        PG8_STAGE(PG8_SB(1, 0), cB + kstep, voffB); PG8_STAGE(PG8_SA(1, 0), cA + kstep, voffA); PG8_STAGE(PG8_SB(1, 1), cB + hstep + kstep, voffB);
        PG8_WAIT_V(6); PG8_BAR;
    }
    for (;;) {
        nxt = S.get(ui + 1); const bool has_next = nxt.nt != 0;
        const char* nA = has_next ? (const char*)g.A + (size_t)nxt.pm * tstep + (size_t)nxt.kofs * 2 : cA; const char* nB = has_next ? (const char*)g.Bt + (size_t)nxt.pn * tstep + (size_t)nxt.kofs * 2 : cB;
        const int nt = cur.nt;
        for (int t = 0; t < nt; t += 2) {
            const bool last = (t == nt - 2);
            const char* a1 = cA + (size_t)(t + 1) * kstep;
            const char* a2 = last ? nA : cA + (size_t)(t + 2) * kstep; const char* b2 = last ? nB : cB + (size_t)(t + 2) * kstep;
            const char* a3 = a2 + kstep; const char* b3 = b2 + kstep;
            if (last && has_next) S.a_ready(nxt);
            if constexpr (SP2) {
            PG8_LDB(B0, 0, 0); PG8_LDB(B1, 0, 1); PG8_SCHED; PG8_LDA(At, 0, 0); PG8_STAGE(PG8_SA(1, 1), a1 + hstep, voffA);
            PG8_WAIT_V(8); PG8_WAIT_L(0); PG8_BAR; PG8_MMA(0, 0, At, B0); PG8_MMA(0, 1, At, B1); PG8_BAR; PG8_SCHED;
            PG8_LDA(At, 0, 1); PG8_STAGE(PG8_SB(0, 0), b2, voffB); PG8_STAGE(PG8_SB(0, 1), b2 + hstep, voffB); PG8_STAGE(PG8_SA(0, 0), a2, voffA);
            PG8_WAIT_V(8); PG8_WAIT_L(0); PG8_BAR; PG8_MMA(1, 0, At, B0); PG8_MMA(1, 1, At, B1); PG8_BAR; PG8_SCHED;
            PG8_LDB(B0, 1, 0); PG8_LDB(B1, 1, 1); PG8_SCHED; PG8_LDA(At, 1, 0); PG8_STAGE(PG8_SA(0, 1), a2 + hstep, voffA);
            PG8_WAIT_V(8); PG8_WAIT_L(0); PG8_BAR; PG8_MMA(0, 0, At, B0); PG8_MMA(0, 1, At, B1); PG8_BAR; PG8_SCHED;
            PG8_LDA(At, 1, 1); PG8_STAGE(PG8_SB(1, 0), b3, voffB); PG8_STAGE(PG8_SB(1, 1), b3 + hstep, voffB); PG8_STAGE(PG8_SA(1, 0), a3, voffA);
            PG8_WAIT_V(8); PG8_WAIT_L(0); PG8_BAR; PG8_MMA(1, 0, At, B0); PG8_MMA(1, 1, At, B1); PG8_BAR; PG8_SCHED;
            } else {
            PG8_LDB(B0, 0, 0); PG8_SCHED; PG8_LDA(At, 0, 0); PG8_STAGE(PG8_SA(1, 1), a1 + hstep, voffA);
            PG8_WAIT_L(8); PG8_BAR; PG8_WAIT_L(0); PG8_MMA(0, 0, At, B0); PG8_BAR; PG8_SCHED;
            PG8_LDB(B1, 0, 1); PG8_STAGE(PG8_SB(0, 0), b2, voffB);
            PG8_BAR; PG8_WAIT_L(0); PG8_MMA(0, 1, At, B1); PG8_BAR;
            PG8_LDA(At, 0, 1); PG8_STAGE(PG8_SA(0, 0), a2, voffA);
            PG8_BAR; PG8_WAIT_L(0); PG8_MMA(1, 0, At, B0); PG8_BAR; PG8_SCHED;
            PG8_STAGE(PG8_SB(0, 1), b2 + hstep, voffB);
            PG8_WAIT_V(6); PG8_BAR; PG8_MMA(1, 1, At, B1); PG8_BAR;
            PG8_LDB(B0, 1, 0); PG8_SCHED; PG8_LDA(At, 1, 0); PG8_STAGE(PG8_SA(0, 1), a2 + hstep, voffA);
            PG8_WAIT_L(8); PG8_BAR; PG8_WAIT_L(0); PG8_MMA(0, 0, At, B0); PG8_BAR; PG8_SCHED;
            PG8_LDB(B1, 1, 1); PG8_STAGE(PG8_SB(1, 0), b3, voffB);
            PG8_BAR; PG8_WAIT_L(0); PG8_MMA(0, 1, At, B1); PG8_BAR;
            PG8_LDA(At, 1, 1); PG8_STAGE(PG8_SA(1, 0), a3, voffA);
            PG8_BAR; PG8_WAIT_L(0); PG8_MMA(1, 0, At, B0); PG8_BAR; PG8_SCHED;
            PG8_STAGE(PG8_SB(1, 1), b3 + hstep, voffB);
            PG8_WAIT_V(6); PG8_BAR; PG8_MMA(1, 1, At, B1); PG8_BAR;
            }
        }
        if constexpr (ALIGN_EPI) { if (wr == 0) PG8_BAR; }
        if constexpr (!Epi::AFTER_DRAIN) { E(acc, cur, wr, wc, fr, fq); S.done(cur); }
        if (!has_next) break;
#pragma unroll
        for (int a = 0; a < 2; ++a)
#pragma unroll
            for (int b = 0; b < 2; ++b)
#pragma unroll
                for (int m = 0; m < 4; ++m)
#pragma unroll
                    for (int n = 0; n < 2; ++n) acc[a][b][m][n] = (f32x4){0.f, 0.f, 0.f, 0.f};
        cur = nxt; cA = nA; cB = nB; ++ui;
        if constexpr (ALIGN_EPI) { if (wr == 1) PG8_BAR; }
    }
    PG8_WAIT_V(0);
    if constexpr (!ALIGN_EPI) { if (wr == 0) PG8_BAR; }
    PG8_BAR;
    if constexpr (Epi::AFTER_DRAIN) { E.fused(acc, cur, wr, wc, fr, fq, lds, wid, lane); S.done(cur); }
#undef PG8_SA
#undef PG8_SB
#undef PG8_STAGE
#undef PG8_LDA
#undef PG8_LDB
#undef PG8_MMA
#undef PG8_WAIT_V
#undef PG8_WAIT_L
#undef PG8_BAR
#undef PG8_SCHED
}
}

constexpr int D = 1024, NIN = 2304, FF = 4096;
constexpr int NB = 8, SEQ = 8192, NPROMPT = NB * SEQ;
constexpr int SB = 16, SS = 32, NSAMP = SB * SS;
constexpr int MTOT = NPROMPT + NSAMP;
constexpr int NMETA = 16, CONVD = 512, QD = 512, KVD = 128, HD = 64;
constexpr int COL_B = 0, COL_C = 512, COL_U = 1024, COL_Q = 1536, COL_K = 2048, COL_V = 2176;
constexpr float EPS = 1e-6f;
constexpr float LOG2E = 1.4426950408889634f;
constexpr float C2 = 0.125f * LOG2E;
constexpr size_t O_YP = 0, O_YS = 67108864, O_PK = 67633152, O_PV = 67764224, O_PMK = 67895296, O_PMV = 67911680, O_PC = 67928064, O_SK = 67936256, O_SV = 68001792, O_SC = 68067328, O_END = 68083712;
constexpr size_t MiB = 1u << 20;
constexpr size_t WS_CTL = 0, CTL_ZERO_BYTES = 64 * 1024;
constexpr size_t WS_WIN = 2 * MiB, WS_WOUT = 8 * MiB, WS_WUP = 10 * MiB, WS_WDN = 18 * MiB;
constexpr size_t WS_METAPROJ = 26 * MiB;
constexpr size_t WS_METAKV = 26 * MiB + 256 * 1024;
constexpr size_t WS_SSQ = 27 * MiB;
constexpr size_t WS_XN2 = 32 * MiB;
constexpr size_t WS_XN0 = 161 * MiB;
constexpr size_t WS_PROJ = 290 * MiB;
constexpr size_t WS_MIX = 581 * MiB;
constexpr size_t WS_HID = 161 * MiB;
constexpr size_t WS_SLAB = 678 * MiB;
constexpr size_t WS_MLP = 710 * MiB;
constexpr size_t WS_END = 839 * MiB;
constexpr int DN_KSPLIT = 16;
static_assert(WS_SSQ + (size_t)MTOT * 16 * 4 <= WS_XN2 && WS_XN2 + (size_t)MTOT * D * 2 <= WS_XN0 && WS_XN0 + (size_t)MTOT * D * 2 <= WS_PROJ && WS_PROJ + (size_t)MTOT * NIN * 2 <= WS_MIX && WS_MIX + (size_t)MTOT * D * 2 <= WS_MLP && WS_MLP + (size_t)MTOT * D * 2 <= WS_END && WS_HID + (size_t)MTOT * FF * 2 <= WS_SLAB, "ws map");

constexpr int NWAVES = 8, NTHREADS = 512;
constexpr int LDS_BYTES = 147456;
constexpr int LDSCTL_OFF = 131072;

#define LAS __attribute__((address_space(3)))
typedef unsigned short bf16;
typedef unsigned v4u __attribute__((ext_vector_type(4)));
typedef float f32x4 __attribute__((ext_vector_type(4)));

__device__ __forceinline__ unsigned f2bf(float f) { unsigned u = __builtin_bit_cast(unsigned, f); return (u + 0x7fffu + ((u >> 16) & 1u)) >> 16; }
__device__ __forceinline__ unsigned pk2(float lo, float hi) { return f2bf(lo) | (f2bf(hi) << 16); }
__device__ __forceinline__ float bflo(unsigned w) { return __builtin_bit_cast(float, w << 16); }
__device__ __forceinline__ float bfhi(unsigned w) { return __builtin_bit_cast(float, w & 0xffff0000u); }
__device__ __forceinline__ float wave_sum(float v) {
#pragma unroll
    for (int o = 1; o < 64; o <<= 1) v += __shfl_xor(v, o);
    return v;
}

#define XB_TMO      128
#define XB_XCNT(j)  (256  + 64 * (j))
#define XB_XSUB(j)  (1280 + 64 * (j))
#define XB_XGEN(j)  (2304 + 64 * (j))
#define XB_TOP      3328
#define XB_TOPGEN   3392
#define XCD_BAR_WORDS 3456
#define XB_SPIN_CAP (1u << 18)

__device__ __forceinline__ unsigned xb_ld(unsigned* p)              { return __hip_atomic_load(p, __ATOMIC_RELAXED, __HIP_MEMORY_SCOPE_AGENT); }
__device__ __forceinline__ unsigned xb_add(unsigned* p, unsigned v) { return __hip_atomic_fetch_add(p, v, __ATOMIC_RELAXED, __HIP_MEMORY_SCOPE_AGENT); }
__device__ __forceinline__ unsigned xb_xcc_id() { return (unsigned)__builtin_amdgcn_s_getreg((3 << 11) | 20) & 0xFu; }
#define XB_SPIN(cond, bar) do { unsigned _sp = 0; while (cond) { __builtin_amdgcn_s_sleep(1); \
    if ((++_sp & 255u) == 0u) { if (xb_ld(&(bar)[XB_TMO])) break; if (_sp > XB_SPIN_CAP) { atomicAdd(&(bar)[XB_TMO], 1u); break; } } } } while (0)

struct XcdBarrier {
    unsigned* bar; unsigned x;
    volatile LAS unsigned* st;
};

__device__ __forceinline__ XcdBarrier xcd_barrier_post(unsigned* bar, volatile LAS unsigned* st) {
    XcdBarrier b; b.bar = bar; b.x = xb_xcc_id(); b.st = st;
    if (threadIdx.x == 0) (void)xb_add(&bar[XB_XCNT(b.x)], 1u);
    return b;
}
__device__ __forceinline__ void xcd_barrier_complete(unsigned* bar, unsigned x, unsigned& nloc, unsigned& nx) {
    const unsigned G = gridDim.x * gridDim.y * gridDim.z;
    unsigned sum, cnt, mine, sp = 0u;
    for (;;) {
        sum = 0u; cnt = 0u; mine = 0u;
#pragma unroll
        for (unsigned j = 0; j < 16; ++j) { const unsigned c = xb_ld(&bar[XB_XCNT(j)]); sum += c; cnt += (c > 0u) ? 1u : 0u; mine = (j == x) ? c : mine; }
        if (sum == G) break;
        __builtin_amdgcn_s_sleep(1);
        if ((++sp & 255u) == 0u) { if (xb_ld(&bar[XB_TMO])) break; if (sp > XB_SPIN_CAP) { atomicAdd(&bar[XB_TMO], 1u); break; } }
    }
    nloc = mine > 0u ? mine : 1u; nx = cnt > 0u ? cnt : 1u;
}

__device__ __forceinline__ void xcd_barrier(const XcdBarrier& b) {
    asm volatile("s_waitcnt vmcnt(0)" ::: "memory");
    __syncthreads();
    if (threadIdx.x == 0) {
        unsigned* bar = b.bar;
        __builtin_amdgcn_s_waitcnt(0);
        unsigned nloc = b.st[0], nx = b.st[1];
        if (nloc == 0u) { xcd_barrier_complete(bar, b.x, nloc, nx); b.st[0] = nloc; b.st[1] = nx; }
        const unsigned old = xb_add(&bar[XB_XSUB(b.x)], 1u);
        const unsigned gen = old / nloc;
        if (old + 1u == (gen + 1u) * nloc) {
            __builtin_amdgcn_fence(__ATOMIC_RELEASE, "agent");
            asm volatile("s_waitcnt vmcnt(0)" ::: "memory");
            const unsigned og = xb_add(&bar[XB_TOP], 1u);
            const unsigned tg = og / nx;
            if (og + 1u == (tg + 1u) * nx) xb_add(&bar[XB_TOPGEN], 1u);
            else XB_SPIN(xb_ld(&bar[XB_TOPGEN]) == tg, bar);
            __builtin_amdgcn_fence(__ATOMIC_ACQUIRE, "agent");
            xb_add(&bar[XB_XGEN(b.x)], 1u);
            asm volatile("s_waitcnt vmcnt(0)" ::: "memory");
        } else {
            XB_SPIN(xb_ld(&bar[XB_XGEN(b.x)]) == gen, bar);
            __builtin_amdgcn_fence(__ATOMIC_ACQUIRE, "agent");
            asm volatile("s_waitcnt vmcnt(0)" ::: "memory");
        }
    }
    __syncthreads();
}

struct Params {
    const float* in[20];
    float* out;
    unsigned char* ws;
};

typedef const __attribute__((address_space(4))) unsigned char* kargp_t;
#define KARGS() kargp_t ka_ = (kargp_t)__builtin_amdgcn_kernarg_segment_ptr(); asm volatile("" : "+s"(ka_))
#define KIN(i) (*(const float* const __attribute__((address_space(4)))*)(ka_ + 8 * (i)))
#define KOUT() (*(float* const __attribute__((address_space(4)))*)(ka_ + 160))
#define KWS() (*(unsigned char* const __attribute__((address_space(4)))*)(ka_ + 168))

__device__ __forceinline__ void p0_transpose_item(const float* W, int K, int N, bf16* WT, const float* gk, LAS float* scr, int item, int lane) {
    const int nblk = N / 32, kb = item / nblk, nb = item % nblk, k0 = 64 * kb, n0 = 32 * nb;
#pragma unroll 8
    for (int i = 0; i < 32; ++i) { const int kk = 2 * i + (lane >> 5); float v = W[(size_t)(k0 + kk) * N + n0 + (lane & 31)]; if (gk) v *= gk[k0 + kk]; scr[kk * 33 + (lane & 31)] = v; }
    asm volatile("s_waitcnt lgkmcnt(0)" ::: "memory");
    const int c = lane & 7;
#pragma unroll
    for (int j = 0; j < 4; ++j) { const int n = (lane >> 3) + 8 * j; const LAS float* s = scr + (8 * c) * 33 + n;
        v4u o; o.x = pk2(s[0 * 33], s[1 * 33]); o.y = pk2(s[2 * 33], s[3 * 33]); o.z = pk2(s[4 * 33], s[5 * 33]); o.w = pk2(s[6 * 33], s[7 * 33]);
        *(v4u*)(WT + (size_t)(n0 + n) * K + k0 + 8 * c) = o; }
    asm volatile("s_waitcnt lgkmcnt(0)" ::: "memory");
}
__device__ __forceinline__ void rms_row_to_bf16(const float* xrow, const float* g, bf16* orow, int lane) {
    const f32x4* xr = (const f32x4*)xrow + lane; const f32x4* gr = (const f32x4*)g + lane;
    f32x4 v[4]; float s = 0.f;
#pragma unroll
    for (int j = 0; j < 4; ++j) { v[j] = xr[64 * j]; s += (v[j].x * v[j].x + v[j].y * v[j].y) + (v[j].z * v[j].z + v[j].w * v[j].w); }
    const float rstd = 1.0f / sqrtf(wave_sum(s) * (1.f / D) + EPS);
    unsigned long long* o8 = (unsigned long long*)orow + lane;
#pragma unroll
    for (int j = 0; j < 4; ++j) { const f32x4 gg = gr[64 * j];
        o8[64 * j] = (unsigned long long)pk2(v[j].x * rstd * gg.x, v[j].y * rstd * gg.y) | ((unsigned long long)pk2(v[j].z * rstd * gg.z, v[j].w * rstd * gg.w) << 32); }
}

__device__ __forceinline__ int t5_bucket(int rel) {
    const int n = rel < 0 ? -rel : rel; int ret = rel > 0 ? 16 : 0;
    if (n < 8) return ret + n;
    int large = (31 - __clz(n * n)) + 2; if (large > 15) large = 15;
    return ret + large;
}


typedef float f32x16 __attribute__((ext_vector_type(16)));
typedef short bf16x8v __attribute__((ext_vector_type(8)));
typedef short v4i16_t __attribute__((ext_vector_type(4)));
template <int NQT>
__device__ __forceinline__ void attn_core(LAS unsigned char* KIMG, LAS unsigned char* VIMG, const LAS float* BREL, LAS float* SSQX, const bf16* PROJ, bf16* MIX, const float* g_attn, const float* sinks,
                                          size_t row0, int kt0, int ntiles, int metaoff, int wave, int lane, const bf16x8v (&qf)[NQT][4]) {
    const int h = wave, kvh = h >> 2, q = lane & 31, hh = lane >> 5;
    f32x16 O[NQT][2]; float m[NQT], l[NQT];
    const float sink2 = sinks[h] * LOG2E;
#pragma unroll
    for (int qt = 0; qt < NQT; ++qt) { m[qt] = sink2; l[qt] = hh == 0 ? 1.f : 0.f;
#pragma unroll
        for (int dt = 0; dt < 2; ++dt)
#pragma unroll
            for (int r = 0; r < 16; ++r) O[qt][dt][r] = 0.f; }
    const int kswz = q & 15;
    int koff[4];
#pragma unroll
    for (int ks = 0; ks < 4; ++ks) koff[ks] = q * 256 + (((kvh * 8 + ks * 2 + hh) ^ kswz) << 4);
    const int G4 = lane >> 4, i16 = lane & 15, vsw = (i16 >> 2) & 3;
    int voff[2];
#pragma unroll
    for (int dt = 0; dt < 2; ++dt) voff[dt] = (4 * (G4 >> 1) + (i16 >> 2)) * 256 + ((((kvh * 2 + dt) ^ vsw) << 6) | ((G4 & 1) * 32 + (i16 & 3) * 8));
    for (int kt = kt0; kt < ntiles; ++kt) {
        bf16x8v kf[4], vf[2][2];
#pragma unroll
        for (int ks = 0; ks < 4; ++ks) kf[ks] = *(const LAS bf16x8v*)(KIMG + kt * 8192 + koff[ks]);
#pragma unroll
        for (int dt = 0; dt < 2; ++dt)
#pragma unroll
            for (int s = 0; s < 2; ++s) {
                const v4i16_t a = __builtin_amdgcn_ds_read_tr16_b64_v4i16((LAS v4i16_t*)(VIMG + kt * 8192 + s * 4096 + voff[dt]));
                const v4i16_t bq = __builtin_amdgcn_ds_read_tr16_b64_v4i16((LAS v4i16_t*)(VIMG + kt * 8192 + s * 4096 + 2048 + voff[dt]));
                vf[dt][s] = (bf16x8v){a[0], a[1], a[2], a[3], bq[0], bq[1], bq[2], bq[3]}; }
        const bool lastt = (kt == ntiles - 1);
#pragma unroll
        for (int qt = 0; qt < NQT; ++qt) {
            f32x16 S;
#pragma unroll
            for (int r = 0; r < 16; ++r) S[r] = 0.f;
#pragma unroll
            for (int ks = 0; ks < 4; ++ks) S = __builtin_amdgcn_mfma_f32_32x32x16_bf16(kf[ks], qf[qt][ks], S, 0, 0, 0);
            const int i = 32 * qt + q;
            float tmax;
            if (!lastt) {
                const LAS float* bp = BREL + h * 256 + (32 * kt + 63 + 4 * hh - i);
#pragma unroll
                for (int r = 0; r < 16; ++r) S[r] = S[r] * C2 + bp[(r & 3) + 8 * (r >> 2)];
                tmax = S[0];
#pragma unroll
                for (int r = 1; r < 16; ++r) tmax = fmaxf(tmax, S[r]);
            } else {
#pragma unroll
                for (int r = 0; r < 8; ++r) { const int kr = (r & 3) + 8 * (r >> 2) + 4 * hh; int rel = kr - metaoff - i; rel = rel < -191 ? -191 : rel; S[r] = S[r] * C2 + BREL[h * 256 + rel + 191]; }
                tmax = S[0];
#pragma unroll
                for (int r = 1; r < 8; ++r) tmax = fmaxf(tmax, S[r]);
#pragma unroll
                for (int r = 8; r < 16; ++r) S[r] = -INFINITY;
            }
            tmax = fmaxf(tmax, __shfl_xor(tmax, 32));
            const float mn = fmaxf(m[qt], tmax), sc = __builtin_amdgcn_exp2f(m[qt] - mn); m[qt] = mn;
            float psum = 0.f;
#pragma unroll
            for (int r = 0; r < 16; ++r) { S[r] = __builtin_amdgcn_exp2f(S[r] - mn); psum += S[r]; }
            l[qt] = l[qt] * sc + psum;
#pragma unroll
            for (int dt = 0; dt < 2; ++dt)
#pragma unroll
                for (int r = 0; r < 16; ++r) O[qt][dt][r] *= sc;
            bf16x8v pf[2];
#pragma unroll
            for (int s = 0; s < 2; ++s) { v4u w; w.x = pg8::cvt_pk_bf16(S[8 * s + 0], S[8 * s + 1]); w.y = pg8::cvt_pk_bf16(S[8 * s + 2], S[8 * s + 3]); w.z = pg8::cvt_pk_bf16(S[8 * s + 4], S[8 * s + 5]); w.w = pg8::cvt_pk_bf16(S[8 * s + 6], S[8 * s + 7]);
                pf[s] = __builtin_bit_cast(bf16x8v, w); }
#pragma unroll
            for (int dt = 0; dt < 2; ++dt)
#pragma unroll
                for (int s = 0; s < 2; ++s) O[qt][dt] = __builtin_amdgcn_mfma_f32_32x32x16_bf16(vf[dt][s], pf[s], O[qt][dt], 0, 0, 0);
        }
    }
#pragma unroll
    for (int qt = 0; qt < NQT; ++qt) {
        const float lt = l[qt] + __shfl_xor(l[qt], 32), inv = 1.0f / lt; float ss = 0.f;
#pragma unroll
        for (int dt = 0; dt < 2; ++dt)
#pragma unroll
            for (int r = 0; r < 16; ++r) { O[qt][dt][r] *= inv; ss += O[qt][dt][r] * O[qt][dt][r]; }
        ss += __shfl_xor(ss, 32);
        if (hh == 0) SSQX[h * 64 + 32 * qt + q] = ss;
    }
    __syncthreads();
#pragma unroll
    for (int qt = 0; qt < NQT; ++qt) {
        float tot = 0.f;
#pragma unroll
        for (int h2 = 0; h2 < 8; ++h2) tot += SSQX[h2 * 64 + 32 * qt + q];
        const float rstd = 1.0f / sqrtf(tot * (1.f / QD) + EPS);
        bf16* mrow = MIX + (row0 + 32 * qt + q) * D + CONVD + 64 * h;
#pragma unroll
        for (int dt = 0; dt < 2; ++dt)
#pragma unroll
            for (int g4 = 0; g4 < 4; ++g4) { const int d0 = 32 * dt + 8 * g4 + 4 * hh; const f32x4 gv = *(const f32x4*)(g_attn + 64 * h + d0);
                pg8::u32x2 w; w.x = pg8::cvt_pk_bf16(O[qt][dt][4 * g4 + 0] * rstd * gv.x, O[qt][dt][4 * g4 + 1] * rstd * gv.y); w.y = pg8::cvt_pk_bf16(O[qt][dt][4 * g4 + 2] * rstd * gv.z, O[qt][dt][4 * g4 + 3] * rstd * gv.w);
                *(pg8::u32x2*)(mrow + d0) = w; }
    }
}


template <bool ISA>
__device__ __forceinline__ void p2_unit(int b, int c, LAS unsigned char* lds, kargp_t ka_, int tid, int wave, int lane) {
    unsigned char* ws = KWS(); const bf16* PROJ = (const bf16*)(ws + WS_PROJ); bf16* MIX = (bf16*)(ws + WS_MIX);
    constexpr int NQT = ISA ? 2 : 1, TPW = ISA ? 8 : 4, NIT = ISA ? 14 : 12, NTILES = ISA ? 7 : 6;
    LAS unsigned char* KIMG = lds; LAS unsigned char* VIMG = lds + 57344; const LAS float* BREL = (const LAS float*)(lds + 114688); LAS float* SSQX = (LAS float*)(lds + 114688 + 8192);
    asm volatile("" : "+v"(lane));
    const size_t row0 = ISA ? (size_t)b * SEQ + 64 * c : (size_t)NPROMPT + 32 * b;
    const int jr = tid >> 5, cc = tid & 31;
    v4u sv[NIT]; f32x4 fa[9], fb[9];
#pragma unroll
    for (int it = 0; it < NIT; ++it) { const int j = jr + 16 * it; sv[it] = (v4u){0u, 0u, 0u, 0u};
        if constexpr (ISA) {
            if (it < 12) { const int tk = 64 * (c - 2) + j; if (tk >= 0) sv[it] = *(const v4u*)(PROJ + ((size_t)b * SEQ + tk) * NIN + COL_K + 8 * cc); }
            else if (it == 12) sv[it] = *(const v4u*)((const bf16*)(ws + WS_METAKV) + (j - 192) * 256 + 8 * cc);
        } else {
            if (it < 8) { const float* src = (cc < 16 ? KIN(2) : KIN(3)) + ((size_t)b * 128 + j) * 128 + 8 * (cc & 15); fa[it] = *(const f32x4*)src; fb[it] = *(const f32x4*)(src + 4); }
            else if (it < 10) sv[it] = *(const v4u*)(PROJ + (row0 + (j - 128)) * NIN + COL_K + 8 * cc);
            else if (it == 10) { const float* src = (cc < 16 ? KIN(4) : KIN(5)) + ((size_t)b * 16 + (j - 160)) * 128 + 8 * (cc & 15); fa[8] = *(const f32x4*)src; fb[8] = *(const f32x4*)(src + 4); }
        } }
    {
        const int ch = 8 * lane; const float* conv_w = KIN(10); const float* g_conv = KIN(13); float* out = KOUT();
        float w0[8], w1[8], w2[8], gc[8];
#pragma unroll
        for (int e = 0; e < 8; ++e) { w0[e] = conv_w[ch + e]; w1[e] = conv_w[CONVD + ch + e]; w2[e] = conv_w[2 * CONVD + ch + e]; gc[e] = g_conv[ch + e]; }
#pragma unroll 1
        for (int hb = 0; hb < TPW / 4; ++hb) {
            const int tb = TPW * wave + 4 * hb;
            v4u cw[6], uw[6], bw[4];
#pragma unroll
            for (int k = 0; k < 6; ++k) { const int t = tb + k - 2; const int tg = ISA ? 64 * c + t : t; cw[k] = (v4u){0u, 0u, 0u, 0u}; uw[k] = cw[k];
                if (tg >= 0) { const bf16* pr = PROJ + (ISA ? (size_t)b * SEQ + tg : (size_t)NPROMPT + 32 * b + tg) * NIN; cw[k] = *(const v4u*)(pr + COL_C + ch); uw[k] = *(const v4u*)(pr + COL_U + ch); } }
#pragma unroll
            for (int k = 0; k < 4; ++k) bw[k] = *(const v4u*)(PROJ + (row0 + tb + k) * NIN + COL_B + ch);
            float ua[8] = {0.f, 0.f, 0.f, 0.f, 0.f, 0.f, 0.f, 0.f}, ub[8] = {0.f, 0.f, 0.f, 0.f, 0.f, 0.f, 0.f, 0.f}, uc[8];
#pragma unroll
            for (int k = 0; k < 6; ++k) {
                const int t = tb + k - 2;
                const int tg = ISA ? 64 * c + t : t;
                if (tg >= 0) { const v4u a = cw[k], bq = uw[k];
                    uc[0] = bflo(a.x) * bflo(bq.x); uc[1] = bfhi(a.x) * bfhi(bq.x); uc[2] = bflo(a.y) * bflo(bq.y); uc[3] = bfhi(a.y) * bfhi(bq.y);
                    uc[4] = bflo(a.z) * bflo(bq.z); uc[5] = bfhi(a.z) * bfhi(bq.z); uc[6] = bflo(a.w) * bflo(bq.w); uc[7] = bfhi(a.w) * bfhi(bq.w); }
                else if (ISA) { const float* mp = (const float*)(ws + WS_METAPROJ) + (size_t)(16 + tg) * NIN;
#pragma unroll
                    for (int e = 0; e < 8; ++e) uc[e] = mp[COL_C + ch + e] * mp[COL_U + ch + e]; }
                else { const float* sp = KIN(6) + ((size_t)b * 2 + (2 + tg)) * CONVD + ch;
#pragma unroll
                    for (int e = 0; e < 8; ++e) uc[e] = sp[e]; }
                if (k >= 2) {
                    const size_t row = row0 + t; const v4u bq = bw[k - 2];
                    const float bv[8] = {bflo(bq.x), bfhi(bq.x), bflo(bq.y), bfhi(bq.y), bflo(bq.z), bfhi(bq.z), bflo(bq.w), bfhi(bq.w)};
                    float y[8]; float ss = 0.f;
#pragma unroll
                    for (int e = 0; e < 8; ++e) { y[e] = bv[e] * (w0[e] * ua[e] + w1[e] * ub[e] + w2[e] * uc[e]); ss += y[e] * y[e]; }
                    const float rstd = 1.0f / sqrtf(wave_sum(ss) * (1.f / CONVD) + EPS);
                    v4u w; w.x = pk2(y[0] * rstd * gc[0], y[1] * rstd * gc[1]); w.y = pk2(y[2] * rstd * gc[2], y[3] * rstd * gc[3]); w.z = pk2(y[4] * rstd * gc[4], y[5] * rstd * gc[5]); w.w = pk2(y[6] * rstd * gc[6], y[7] * rstd * gc[7]);
                    *(v4u*)(MIX + row * D + ch) = w;
                    const int last = ISA ? (c == SEQ / 64 - 1 ? 64 : 1 << 30) : 32;
                    if (t >= last - 2) { float* dst = (ISA ? out + O_PC + ((size_t)b * 2 + (t - (last - 2))) * CONVD : out + O_SC + ((size_t)b * 2 + (t - (last - 2))) * CONVD) + ch;
#pragma unroll
                        for (int e = 0; e < 8; ++e) dst[e] = uc[e]; }
                }
#pragma unroll
                for (int e = 0; e < 8; ++e) { ua[e] = ub[e]; ub[e] = uc[e]; }
            }
        }
    }
    bf16x8v qf[NQT][4];
    { const int q = lane & 31, hh = lane >> 5;
#pragma unroll
      for (int qt = 0; qt < NQT; ++qt)
#pragma unroll
          for (int ks = 0; ks < 4; ++ks) qf[qt][ks] = *(const bf16x8v*)(PROJ + (row0 + 32 * qt + q) * NIN + COL_Q + 64 * wave + 16 * ks + 8 * hh); }
    if (ISA) { if (c >= 126) { float* out = KOUT(); for (int o = tid; o < 64 * 256; o += NTHREADS) { const int i = o >> 8, col = o & 255; const float v = __builtin_bit_cast(float, (unsigned)PROJ[(row0 + i) * NIN + COL_K + col] << 16); const int t = 64 * (c - 126) + i;
            if (col < 128) out[O_PK + ((size_t)b * 128 + t) * 128 + col] = v; else out[O_PV + ((size_t)b * 128 + t) * 128 + (col - 128)] = v; } } }
    else { float* out = KOUT(); for (int o = tid; o < 32 * 256; o += NTHREADS) { const int i = o >> 8, col = o & 255; const float v = __builtin_bit_cast(float, (unsigned)PROJ[(row0 + i) * NIN + COL_K + col] << 16);
            if (col < 128) out[O_SK + ((size_t)b * 32 + i) * 128 + col] = v; else out[O_SV + ((size_t)b * 32 + i) * 128 + (col - 128)] = v; } }
    __syncthreads();
#pragma unroll
    for (int it = 0; it < NIT; ++it) { const int j = jr + 16 * it; v4u val = sv[it];
        if constexpr (!ISA) { if (it < 8 || it == 10) { const f32x4 a = fa[it < 8 ? it : 8], bb = fb[it < 8 ? it : 8]; val.x = pk2(a.x, a.y); val.y = pk2(a.z, a.w); val.z = pk2(bb.x, bb.y); val.w = pk2(bb.z, bb.w); } }
        if (cc < 16) *(LAS v4u*)(KIMG + j * 256 + ((cc ^ (j & 15)) << 4)) = val;
        else { const int c2 = cc - 16; *(LAS v4u*)(VIMG + j * 256 + (((((c2 >> 2) ^ (j & 3)) << 2) | (c2 & 3)) << 4)) = val; } }
    __syncthreads();
    attn_core<NQT>(KIMG, VIMG, BREL, SSQX, PROJ, MIX, KIN(14), KIN(11), row0, ISA ? (c >= 2 ? 0 : 4 - 2 * c) : 0, NTILES, ISA ? 16 + 64 * c : 16 + 4096, wave, lane, qf);
}

__global__ void __launch_bounds__(NTHREADS, 2) fwd_kernel(Params p) {
    extern __shared__ __attribute__((aligned(16))) unsigned char lds_raw[];
    LAS unsigned char* lds = (LAS unsigned char*)lds_raw;
#define TIDVARS() int tid = threadIdx.x; asm volatile("" : "+v"(tid)); const int lane = tid & 63, wave = __builtin_amdgcn_readfirstlane(tid >> 6); (void)lane; (void)wave
    const int G = gridDim.x, bid = blockIdx.x;
    if (threadIdx.x < 16) ((LAS unsigned*)(lds + LDSCTL_OFF))[threadIdx.x] = 0u;
    __syncthreads();
    const XcdBarrier bar = xcd_barrier_post((unsigned*)(*(unsigned char* const __attribute__((address_space(4)))*)((const __attribute__((address_space(4))) unsigned char*)__builtin_amdgcn_kernarg_segment_ptr() + 168) + WS_CTL) + 1024, (volatile LAS unsigned*)(lds + LDSCTL_OFF));
    {
        TIDVARS(); KARGS(); unsigned char* ws = KWS(); float* out = KOUT();
        const float* x_prompt = KIN(0); const float* x_sample = KIN(1); const float* meta_tokens = KIN(7); const float* g_mix = KIN(8); const float* w_in = KIN(9);
        const float* w_out = KIN(15); const float* g_mlp = KIN(16); const float* w_up = KIN(17); const float* w_down = KIN(18);
        bf16* WinT = (bf16*)(ws + WS_WIN); bf16* WoutT = (bf16*)(ws + WS_WOUT); bf16* WupT = (bf16*)(ws + WS_WUP); bf16* WdnT = (bf16*)(ws + WS_WDN);
        float* METAPROJ = (float*)(ws + WS_METAPROJ); bf16* METAKV = (bf16*)(ws + WS_METAKV); bf16* XN0 = (bf16*)(ws + WS_XN0);
        if (bid < NIN / 64) {
            LAS float* xnT = (LAS float*)lds;
            LAS float* red = (LAS float*)(lds + 65536);
            for (int rr = 0; rr < 2; ++rr) { const int r = 2 * wave + rr; const f32x4* xr = (const f32x4*)(meta_tokens + (size_t)r * D) + lane; const f32x4* gr = (const f32x4*)g_mix + lane;
                f32x4 v[4]; float s = 0.f;
#pragma unroll
                for (int j = 0; j < 4; ++j) { v[j] = xr[64 * j]; s += (v[j].x * v[j].x + v[j].y * v[j].y) + (v[j].z * v[j].z + v[j].w * v[j].w); }
                const float rstd = 1.0f / sqrtf(wave_sum(s) * (1.f / D) + EPS);
#pragma unroll
                for (int j = 0; j < 4; ++j) { const f32x4 gg = gr[64 * j]; const int k = 4 * lane + 256 * j;
                    xnT[(k + 0) * 16 + r] = v[j].x * rstd * gg.x; xnT[(k + 1) * 16 + r] = v[j].y * rstd * gg.y; xnT[(k + 2) * 16 + r] = v[j].z * rstd * gg.z; xnT[(k + 3) * 16 + r] = v[j].w * rstd * gg.w; } }
            __syncthreads();
            const int n = 64 * bid + lane; float acc[16];
#pragma unroll
            for (int r = 0; r < 16; ++r) acc[r] = 0.f;
            for (int k0 = 128 * wave; k0 < 128 * wave + 128; k0 += 8) { float wv[8];
#pragma unroll
                for (int kk = 0; kk < 8; ++kk) wv[kk] = w_in[(size_t)(k0 + kk) * NIN + n];
#pragma unroll
                for (int kk = 0; kk < 8; ++kk) { const LAS f32x4* xs = (const LAS f32x4*)(xnT + (k0 + kk) * 16);
#pragma unroll
                    for (int q = 0; q < 4; ++q) { const f32x4 xv = xs[q]; acc[4 * q + 0] += xv.x * wv[kk]; acc[4 * q + 1] += xv.y * wv[kk]; acc[4 * q + 2] += xv.z * wv[kk]; acc[4 * q + 3] += xv.w * wv[kk]; } } }
#pragma unroll
            for (int r = 0; r < 16; ++r) red[(wave * 16 + r) * 64 + lane] = acc[r];
            __syncthreads();
            for (int o = tid; o < 1024; o += NTHREADS) { const int r = o >> 6, l = o & 63; float s = 0.f;
#pragma unroll
                for (int w = 0; w < 8; ++w) s += red[(w * 16 + r) * 64 + l];
                const int nn = 64 * bid + l; METAPROJ[r * NIN + nn] = s;
                if (nn >= COL_K) { const int kc = nn - COL_K; METAKV[r * 256 + kc] = (bf16)f2bf(s);
                    float* dst = (kc < 128) ? out + O_PMK + r * 128 + kc : out + O_PMV + r * 128 + (kc - 128);
#pragma unroll
                    for (int b = 0; b < NB; ++b) dst[(size_t)b * NMETA * 128] = s; } }
            __syncthreads();
        }
        LAS float* scr = (LAS float*)(lds + wave * 16384);
        const int gw = bid * NWAVES + wave, NGW = G * NWAVES;
        constexpr int I_IN = (D / 64) * (NIN / 32), I_OUT = (D / 64) * (D / 32), I_UP = (D / 64) * (FF / 32), I_DN = (FF / 64) * (D / 32);
        constexpr int NITEMS = I_IN + I_OUT + I_UP + I_DN;
        for (int it = gw; it < NITEMS; it += NGW) {
            int r = it;
            if (r < I_IN) { p0_transpose_item(w_in, D, NIN, WinT, nullptr, scr, r, lane); continue; } r -= I_IN;
            if (r < I_OUT) { p0_transpose_item(w_out, D, D, WoutT, nullptr, scr, r, lane); continue; } r -= I_OUT;
            if (r < I_UP) { p0_transpose_item(w_up, D, FF, WupT, g_mlp, scr, r, lane); continue; } r -= I_UP;
            p0_transpose_item(w_down, FF, D, WdnT, nullptr, scr, r, lane);
        }
        {
            const int nmw = (NIN / 64) * NWAVES; int m0, m1;
            if (G == 256) { m0 = gw < nmw ? gw * 16 : nmw * 16 + (gw - nmw) * 35; m1 = m0 + (gw < nmw ? 16 : 35); } else { const int per = (MTOT + NGW - 1) / NGW; m0 = gw * per; m1 = m0 + per; }
            if (m1 > MTOT) m1 = MTOT;
            for (int m = m0; m < m1; ++m) {
                const float* xrow = (m < NPROMPT) ? x_prompt + (size_t)m * D : x_sample + (size_t)(m - NPROMPT) * D;
                rms_row_to_bf16(xrow, g_mix, XN0 + (size_t)m * D, lane);
            }
        }
    }
    xcd_barrier(bar);

    {
        KARGS(); unsigned char* ws = KWS(); bf16* WinT = (bf16*)(ws + WS_WIN); bf16* XN0 = (bf16*)(ws + WS_XN0); bf16* PROJ = (bf16*)(ws + WS_PROJ);
        pg8::Gemm g{XN0, WinT, MTOT, NIN, D}; typedef pg8::PhaseOrder<NPROMPT / 256, NSAMP / 256, NIN, D, 1> Ord; Ord S; S.init(G, bid);
        pg8::EpiProj E{PROJ, NIN};
        pg8::gemm_phase<pg8::EpiProj, Ord, true, true>(lds, g, S, E);
    }
    xcd_barrier(bar);

    {
        TIDVARS(); KARGS(); const float* rel_table = KIN(12);
        LAS unsigned char* KIMG = lds;
        LAS unsigned char* VIMG = lds + 57344;
        LAS float* BREL = (LAS float*)(lds + 114688);
        LAS float* SSQX = (LAS float*)(lds + 114688 + 8192);
        for (int o = tid; o < 8 * 256; o += NTHREADS) { const int h = o >> 8, idx = o & 255; const int rel = idx - 191; BREL[o] = (idx < 255) ? rel_table[t5_bucket(rel) * 8 + h] * LOG2E : 0.f; }
        __syncthreads();
        const int NUNITS = NB * (SEQ / 64) + SB;
        for (int u = bid; u < NUNITS; u += G) {
            if (u < NB * (SEQ / 64)) p2_unit<true>(u / (SEQ / 64), u % (SEQ / 64), lds, ka_, tid, wave, lane);
            else p2_unit<false>(u - NB * (SEQ / 64), 0, lds, ka_, tid, wave, lane);
        }
    }
    xcd_barrier(bar);

    {
        KARGS(); unsigned char* ws = KWS(); const float* x_prompt = KIN(0); const float* x_sample = KIN(1);
        bf16* WoutT = (bf16*)(ws + WS_WOUT); bf16* MIX = (bf16*)(ws + WS_MIX); bf16* XN2 = (bf16*)(ws + WS_XN2); float* SSQ = (float*)(ws + WS_SSQ);
        pg8::Gemm g{MIX, WoutT, MTOT, D, D}; typedef pg8::PhaseOrder<NPROMPT / 256, NSAMP / 256, D, D, 1> Ord; Ord S; S.init(G, bid);
        pg8::EpiOut E{x_prompt, x_sample, XN2, SSQ, NPROMPT};
        pg8::gemm_phase<pg8::EpiOut, Ord, true, true>(lds, g, S, E);
    }
    xcd_barrier(bar);

    {
        KARGS(); unsigned char* ws = KWS(); bf16* WupT = (bf16*)(ws + WS_WUP); bf16* XN2 = (bf16*)(ws + WS_XN2); bf16* HID = (bf16*)(ws + WS_HID);
        pg8::Gemm g{XN2, WupT, MTOT, FF, D}; typedef pg8::PhaseOrder<NPROMPT / 256, NSAMP / 256, FF, D, 1> Ord; Ord S; S.init(G, bid);
        pg8::EpiUp E{HID, FF};
        pg8::gemm_phase<pg8::EpiUp, Ord, true, true>(lds, g, S, E);
    }
    xcd_barrier(bar);

    {
        KARGS(); unsigned char* ws = KWS(); bf16* WdnT = (bf16*)(ws + WS_WDN); bf16* HID = (bf16*)(ws + WS_HID);
        pg8::Gemm g{HID, WdnT, MTOT, D, FF}; typedef pg8::PhaseOrder<NPROMPT / 256, NSAMP / 256, D, FF, DN_KSPLIT> Ord; Ord S; S.init(G, bid);
        pg8::EpiDown E{(bf16*)(ws + WS_MLP), (float*)(ws + WS_SLAB), NPROMPT / 256, NSAMP};
        pg8::gemm_phase<pg8::EpiDown, Ord, true, true>(lds, g, S, E);
    }
    xcd_barrier(bar);

    {
        TIDVARS(); KARGS(); unsigned char* ws = KWS(); float* out = KOUT(); const float* g_final = KIN(19);
        const bf16* XN2 = (const bf16*)(ws + WS_XN2); const bf16* MLP = (const bf16*)(ws + WS_MLP); const float* SSQ = (const float*)(ws + WS_SSQ); const float* SLAB = (const float*)(ws + WS_SLAB);
        const int gw = bid * NWAVES + wave, NGW = G * NWAVES;
        for (int m = gw; m < MTOT; m += NGW) {
            const v4u h0 = *((const v4u*)(XN2 + (size_t)m * D) + lane), h1 = *((const v4u*)(XN2 + (size_t)m * D) + 64 + lane);
            float ssq1 = (lane < 16) ? SSQ[(size_t)m * 16 + lane] : 0.f;
            float a[16];
            if (m < NPROMPT) {
                const v4u m0 = *((const v4u*)(MLP + (size_t)m * D) + lane), m1 = *((const v4u*)(MLP + (size_t)m * D) + 64 + lane);
                a[0] = bflo(m0.x); a[1] = bfhi(m0.x); a[2] = bflo(m0.y); a[3] = bfhi(m0.y); a[4] = bflo(m0.z); a[5] = bfhi(m0.z); a[6] = bflo(m0.w); a[7] = bfhi(m0.w);
                a[8] = bflo(m1.x); a[9] = bfhi(m1.x); a[10] = bflo(m1.y); a[11] = bfhi(m1.y); a[12] = bflo(m1.z); a[13] = bfhi(m1.z); a[14] = bflo(m1.w); a[15] = bfhi(m1.w);
            } else {
#pragma unroll
                for (int e = 0; e < 16; ++e) a[e] = 0.f;
                const float* sl = SLAB + (size_t)(m - NPROMPT) * D + 8 * lane;
                for (int ks = 0; ks < DN_KSPLIT; ++ks, sl += (size_t)NSAMP * D) { const f32x4 s0 = *(const f32x4*)sl, s1 = *(const f32x4*)(sl + 4), s2 = *(const f32x4*)(sl + 512), s3 = *(const f32x4*)(sl + 516);
                    a[0] += s0.x; a[1] += s0.y; a[2] += s0.z; a[3] += s0.w; a[4] += s1.x; a[5] += s1.y; a[6] += s1.z; a[7] += s1.w;
                    a[8] += s2.x; a[9] += s2.y; a[10] += s2.z; a[11] += s2.w; a[12] += s3.x; a[13] += s3.y; a[14] += s3.z; a[15] += s3.w; } }
            const float r2 = 1.0f / (wave_sum(ssq1) * (1.f / D) + EPS);
            float h[16] = {bflo(h0.x), bfhi(h0.x), bflo(h0.y), bfhi(h0.y), bflo(h0.z), bfhi(h0.z), bflo(h0.w), bfhi(h0.w), bflo(h1.x), bfhi(h1.x), bflo(h1.y), bfhi(h1.y), bflo(h1.z), bfhi(h1.z), bflo(h1.w), bfhi(h1.w)};
            float s = 0.f;
#pragma unroll
            for (int e = 0; e < 16; ++e) { h[e] += r2 * a[e]; s += h[e] * h[e]; }
            const float rstd = 1.0f / sqrtf(wave_sum(s) * (1.f / D) + EPS);
            const f32x4* gp = (const f32x4*)(g_final + 8 * lane); const f32x4 g0 = gp[0], g1 = gp[1], g2 = gp[128], g3 = gp[129];
            f32x4* op = (f32x4*)(out + (size_t)m * D + 8 * lane);
            op[0] = (f32x4){h[0] * rstd * g0.x, h[1] * rstd * g0.y, h[2] * rstd * g0.z, h[3] * rstd * g0.w};
            op[1] = (f32x4){h[4] * rstd * g1.x, h[5] * rstd * g1.y, h[6] * rstd * g1.z, h[7] * rstd * g1.w};
            op[128] = (f32x4){h[8] * rstd * g2.x, h[9] * rstd * g2.y, h[10] * rstd * g2.z, h[11] * rstd * g2.w};
            op[129] = (f32x4){h[12] * rstd * g3.x, h[13] * rstd * g3.y, h[14] * rstd * g3.z, h[15] * rstd * g3.w};
        }
    }
}

extern "C" void kernel_launch(void* const* d_in, const int* in_sizes, int n_in, void* d_out, int out_size, void* d_ws, size_t ws_size, hipStream_t stream) {
    static int grid = 0;
    if (grid == 0) {
        if (n_in != 20 || in_sizes[0] != NPROMPT * D || out_size != (int)O_END || ws_size < WS_END) { fprintf(stderr, "kernel_launch: unexpected shapes (n_in %d, in0 %d, out %d, ws %zu)\n", n_in, n_in > 0 ? in_sizes[0] : -1, out_size, ws_size); grid = -1; return; }
        int dev = 0, cus = 0, per_cu = 0;
        if (hipGetDevice(&dev) != hipSuccess || hipDeviceGetAttribute(&cus, hipDeviceAttributeMultiprocessorCount, dev) != hipSuccess) { grid = -1; return; }
        if (hipFuncSetAttribute((const void*)fwd_kernel, hipFuncAttributeMaxDynamicSharedMemorySize, LDS_BYTES) != hipSuccess) { fprintf(stderr, "kernel_launch: hipFuncSetAttribute failed\n"); grid = -1; return; }
        if (hipOccupancyMaxActiveBlocksPerMultiprocessor(&per_cu, (const void*)fwd_kernel, NTHREADS, LDS_BYTES) != hipSuccess || per_cu < 1) { fprintf(stderr, "kernel_launch: occupancy query says %d blocks per CU\n", per_cu); (void)hipGetLastError(); grid = -1; return; }
        grid = cus;
    }
    if (grid < 0) return;
    Params p{};
    for (int i = 0; i < 20; ++i) p.in[i] = (const float*)d_in[i];
    p.out = (float*)d_out; p.ws = (unsigned char*)d_ws;
    if (hipMemsetAsync((char*)d_ws + WS_CTL, 0, CTL_ZERO_BYTES, stream) != hipSuccess) { fprintf(stderr, "kernel_launch: memset failed\n"); return; }
    hipLaunchKernelGGL(fwd_kernel, dim3(grid), dim3(NTHREADS), LDS_BYTES, stream, p);
    const hipError_t e = hipPeekAtLastError();
    if (e != hipSuccess) fprintf(stderr, "kernel_launch: launch failed: %s (grid %d)\n", hipGetErrorString(e), grid);
}
```

```cpp
#include <hip/hip_runtime.h>
#include <cstdio>
#include <cstdint>
namespace pg8 {
#define PG8_LAS __attribute__((address_space(3)))
typedef unsigned short bf16_t;
typedef short bf16x8 __attribute__((ext_vector_type(8)));
typedef float f32x4 __attribute__((ext_vector_type(4)));
typedef unsigned u32x4 __attribute__((ext_vector_type(4)));
constexpr int BM = 256, BK = 64, HALF = 128, HTB = HALF * BK * 2  , STAGE_BYTES = 8 * HTB, NXCD = 8, WGM = 8;

__host__ __device__ __forceinline__ int lds_byte(int r, int c) { const int st = (r >> 4) * 2 + (c >> 5), rr = r & 15, cc = c & 31, ob = rr * 64 + cc * 2; return st * 1024 + (ob ^ (((ob >> 9) & 1) << 5)); }
__host__ __device__ __forceinline__ void stage_rc(int b, int& R, int& C) { const int st = b / 1024, sb = b % 1024, swz = sb ^ (((sb >> 9) & 1) << 5); R = (st >> 1) * 16 + swz / 64; C = (st & 1) * 32 + (swz % 64) / 2; }
__host__ __device__ __forceinline__ int perm32(int rho) { const int n = rho >> 4, i = rho & 15; return 8 * (i >> 2) + 4 * n + (i & 3); }

struct Unit { int pm, pn, kofs, nt, ks; };
struct Gemm { const bf16_t* A; const bf16_t* Bt; int M, N, K; };

struct StaticOrder {
    int nM, nN, nwg, G, c;
    __host__ __device__ __forceinline__ void init(int M, int N, int G_, int c_) { nM = M / BM; nN = N / BM; nwg = nM * nN; G = G_; c = c_; }
    __host__ __device__ __forceinline__ bool next(int i, Unit& u) const {
        const long L = (long)i * G + c; if (L >= nwg) return false;
        int wgid = (int)L; { const int q = nwg / NXCD, r = nwg % NXCD, xcd = wgid % NXCD, off = wgid / NXCD; wgid = (xcd < r ? xcd * (q + 1) : r * (q + 1) + (xcd - r) * q) + off; }
        const int nig = WGM * nN, gid = wgid / nig, fm = gid * WGM, gsz = (nM - fm) < WGM ? (nM - fm) : WGM;
        u.pm = fm + ((wgid % nig) % gsz); u.pn = (wgid % nig) / gsz; return true;
    }
    __device__ __forceinline__ void a_ready(const Unit&) const {}
    __device__ __forceinline__ void done(const Unit&) const {}
};

template <int NMP, int NMS, int N, int K, int KSPLIT>
struct PhaseOrder {
    static constexpr int nN = N / BM, nwg = NMP * nN, ntfull = K / BK, nextra = NMS * nN * KSPLIT;
    int G, c;
    __device__ __forceinline__ void init(int G_, int c_) { G = G_; c = c_; }
    __device__ __forceinline__ Unit get(int i) const {
        const int L = i * G + c; Unit u;
        if (L < nwg) {
            int wgid = L; { constexpr int q = nwg / NXCD, r = nwg % NXCD; const int xcd = wgid % NXCD, off = wgid / NXCD; wgid = (xcd < r ? xcd * (q + 1) : r * (q + 1) + (xcd - r) * q) + off; }
            constexpr int nig = WGM * nN; const int gid = wgid / nig, fm = gid * WGM, gsz = (NMP - fm) < WGM ? (NMP - fm) : WGM;
            u.pm = fm + ((wgid % nig) % gsz); u.pn = (wgid % nig) / gsz; u.kofs = 0; u.nt = ntfull; u.ks = 0;
        } else {
            const int e = L - nwg;
            u.ks = e % KSPLIT; u.pn = (e / KSPLIT) % nN; u.pm = NMP + e / (KSPLIT * nN); u.nt = (e < nextra) ? ntfull / KSPLIT : 0; u.kofs = u.ks * (ntfull / KSPLIT) * BK;
        }
        return u;
    }
    __device__ __forceinline__ void a_ready(const Unit&) const {}
    __device__ __forceinline__ void done(const Unit&) const {}
};
__device__ __forceinline__ unsigned cvt_pk_bf16(float lo, float hi) { unsigned r; asm volatile("v_cvt_pk_bf16_f32 %0, %1, %2" : "=v"(r) : "v"(lo), "v"(hi)); return r; }
typedef unsigned u32x2 __attribute__((ext_vector_type(2)));
constexpr float RMS_EPS = 1e-6f;

struct EpiProj {
    static constexpr bool PERM = true, AFTER_DRAIN = false;
    bf16_t* O; int ldc;
    __device__ __forceinline__ void operator()(const f32x4 (&acc)[2][2][4][2], const Unit& u, int wr, int wc, int fr, int fq) const {
        const int row0 = u.pm * BM + wr * 64 + fr, col0 = u.pn * BM + wc * 32 + 8 * fq;
#pragma unroll
        for (int ai = 0; ai < 2; ++ai)
#pragma unroll
            for (int m = 0; m < 4; ++m) { bf16_t* rowp = O + (size_t)(row0 + ai * HALF + m * 16) * ldc + col0;
#pragma unroll
                for (int bj = 0; bj < 2; ++bj) { const f32x4 v0 = acc[ai][bj][m][0], v1 = acc[ai][bj][m][1];
                    u32x4 w; w.x = cvt_pk_bf16(v0[0], v0[1]); w.y = cvt_pk_bf16(v0[2], v0[3]); w.z = cvt_pk_bf16(v1[0], v1[1]); w.w = cvt_pk_bf16(v1[2], v1[3]);
                    *(u32x4*)(rowp + bj * HALF) = w; } }
    }
};
struct EpiUp {
    static constexpr bool PERM = true, AFTER_DRAIN = false;
    bf16_t* O; int ldc;
    __device__ __forceinline__ void operator()(const f32x4 (&acc)[2][2][4][2], const Unit& u, int wr, int wc, int fr, int fq) const {
        const int row0 = u.pm * BM + wr * 64 + fr, col0 = u.pn * BM + wc * 32 + 8 * fq;
#pragma unroll
        for (int ai = 0; ai < 2; ++ai)
#pragma unroll
            for (int m = 0; m < 4; ++m) { bf16_t* rowp = O + (size_t)(row0 + ai * HALF + m * 16) * ldc + col0;
#pragma unroll
                for (int bj = 0; bj < 2; ++bj) { f32x4 v0 = acc[ai][bj][m][0], v1 = acc[ai][bj][m][1];
#pragma unroll
                    for (int e = 0; e < 4; ++e) { v0[e] = fmaxf(v0[e], 0.f); v0[e] *= v0[e]; v1[e] = fmaxf(v1[e], 0.f); v1[e] *= v1[e]; }
                    u32x4 w; w.x = cvt_pk_bf16(v0[0], v0[1]); w.y = cvt_pk_bf16(v0[2], v0[3]); w.z = cvt_pk_bf16(v1[0], v1[1]); w.w = cvt_pk_bf16(v1[2], v1[3]);
                    *(u32x4*)(rowp + bj * HALF) = w; } }
    }
};
struct EpiOut {
    static constexpr bool PERM = false, AFTER_DRAIN = false;
    const float* xp; const float* xs; bf16_t* xn; float* ssq; int nprompt;
    __device__ __forceinline__ void operator()(const f32x4 (&acc)[2][2][4][2], const Unit& u, int wr, int wc, int fr, int fq) const {
        const int col0 = u.pn * BM + wc * 32 + 4 * fq;
        const int rowb = u.pm * BM + wr * 64 + fr;
        const float* base = (rowb < nprompt) ? xp + (size_t)rowb * 1024 : xs + (size_t)(rowb - nprompt) * 1024;
#pragma unroll
        for (int ai = 0; ai < 2; ++ai) {
            f32x4 pre[4][2][2];
#pragma unroll
            for (int m = 0; m < 4; ++m)
#pragma unroll
                for (int bj = 0; bj < 2; ++bj)
#pragma unroll
                    for (int n = 0; n < 2; ++n) pre[m][bj][n] = *(const f32x4*)(base + (size_t)(ai * HALF + m * 16) * 1024 + col0 + bj * HALF + n * 16);
#pragma unroll
            for (int m = 0; m < 4; ++m) { const int row = rowb + ai * HALF + m * 16;
                float q = 0.f;
#pragma unroll
                for (int bj = 0; bj < 2; ++bj)
#pragma unroll
                    for (int n = 0; n < 2; ++n) { const int c = col0 + bj * HALF + n * 16; const f32x4 h = pre[m][bj][n] + acc[ai][bj][m][n];
                        u32x2 w; w.x = cvt_pk_bf16(h[0], h[1]); w.y = cvt_pk_bf16(h[2], h[3]); *(u32x2*)(xn + (size_t)row * 1024 + c) = w;
                        q += (h[0] * h[0] + h[1] * h[1]) + (h[2] * h[2] + h[3] * h[3]); }
                q += __shfl_xor(q, 16); q += __shfl_xor(q, 32);
                if (fq == 0) ssq[(size_t)row * 16 + u.pn * 4 + wc] = q; }
            asm volatile("" ::: "memory");
        }
    }
};
struct EpiDown {
    static constexpr bool PERM = true, AFTER_DRAIN = false;
    bf16_t* O; float* slab; int nMp; int nsrows;
    __device__ __forceinline__ void operator()(const f32x4 (&acc)[2][2][4][2], const Unit& u, int wr, int wc, int fr, int fq) const {
        const int col0 = u.pn * BM + wc * 32 + 8 * fq;
        if (u.pm < nMp) {
            const int row0 = u.pm * BM + wr * 64 + fr;
#pragma unroll
            for (int ai = 0; ai < 2; ++ai)
#pragma unroll
                for (int m = 0; m < 4; ++m) { bf16_t* rowp = O + (size_t)(row0 + ai * HALF + m * 16) * 1024 + col0;
#pragma unroll
                    for (int bj = 0; bj < 2; ++bj) { const f32x4 v0 = acc[ai][bj][m][0], v1 = acc[ai][bj][m][1];
                        u32x4 w; w.x = cvt_pk_bf16(v0[0], v0[1]); w.y = cvt_pk_bf16(v0[2], v0[3]); w.z = cvt_pk_bf16(v1[0], v1[1]); w.w = cvt_pk_bf16(v1[2], v1[3]);
                        *(u32x4*)(rowp + bj * HALF) = w; } }
        } else {
            float* sl = slab + (size_t)u.ks * nsrows * 1024;
#pragma unroll
            for (int ai = 0; ai < 2; ++ai)
#pragma unroll
                for (int m = 0; m < 4; ++m) { const int row = (u.pm - nMp) * BM + ai * HALF + wr * 64 + m * 16 + fr; float* rowp = sl + (size_t)row * 1024 + col0;
#pragma unroll
                    for (int bj = 0; bj < 2; ++bj)
#pragma unroll
                        for (int n = 0; n < 2; ++n) *(f32x4*)(rowp + bj * HALF + n * 4) = acc[ai][bj][m][n]; }
        }
    }
};

template <class Epi, class Sched, bool ALIGN_EPI = false, bool SP2 = false>
__device__ __forceinline__ void gemm_phase(PG8_LAS unsigned char* lds, const Gemm g, const Sched& S, const Epi& E) {
    int tid_l = threadIdx.x; asm volatile("" : "+v"(tid_l));
    const int tid = tid_l, wid = __builtin_amdgcn_readfirstlane(tid >> 6), lane = tid & 63, wr = wid >> 2, wc = wid & 3, fr = lane & 15, fq = lane >> 4;
    const int K = g.K;
    unsigned voffA[2], voffB[2];
#pragma unroll
    for (int i = 0; i < 2; ++i) { int R, C; stage_rc(tid * 16 + i * 8192, R, C); const int Rb = Epi::PERM ? ((R & ~31) + perm32(R & 31)) : R;
        voffA[i] = (unsigned)(R * K + C) * 2u; voffB[i] = (unsigned)(Rb * K + C) * 2u; }
    const size_t kstep = (size_t)(BK * 2);
    const size_t hstep = (size_t)HALF * K * 2;
    const size_t tstep = 2 * hstep;
    const unsigned ldsw = (unsigned)wid * 1024u;
    const int aoff = lds_byte(wr * 64 + fr, fq * 8), boff = lds_byte(wc * 32 + fr, fq * 8);
#define PG8_SA(b, h) (((b) * 2 + (h)) * HTB)
#define PG8_SB(b, h) ((4 + (b) * 2 + (h)) * HTB)
#define PG8_STAGE(bufoff, gbase, voff) do { _Pragma("unroll") for (int _i = 0; _i < 2; ++_i) \
        __builtin_amdgcn_global_load_lds((const unsigned*)((const char*)(gbase) + (voff)[_i]), (PG8_LAS unsigned*)(lds + (bufoff) + ldsw + _i * 8192), 16, 0, 0); } while (0)
#define PG8_LDA(dst, b, h) do { _Pragma("unroll") for (int m = 0; m < 4; ++m) _Pragma("unroll") for (int k = 0; k < 2; ++k) dst[m][k] = *(const PG8_LAS bf16x8*)(lds + PG8_SA(b, h) + aoff + m * 2048 + k * 1024); } while (0)
#define PG8_LDB(dst, b, h) do { _Pragma("unroll") for (int n = 0; n < 2; ++n) _Pragma("unroll") for (int k = 0; k < 2; ++k) dst[n][k] = *(const PG8_LAS bf16x8*)(lds + PG8_SB(b, h) + boff + n * 2048 + k * 1024); } while (0)
#define PG8_MMA(ai, bj, At, Bt) do { __builtin_amdgcn_s_setprio(1); _Pragma("unroll") for (int m = 0; m < 4; ++m) _Pragma("unroll") for (int n = 0; n < 2; ++n) _Pragma("unroll") for (int k = 0; k < 2; ++k) \
        acc[ai][bj][m][n] = __builtin_amdgcn_mfma_f32_16x16x32_bf16(Bt[n][k], At[m][k], acc[ai][bj][m][n], 0, 0, 0); __builtin_amdgcn_s_setprio(0); } while (0)
#define PG8_WAIT_V(n) asm volatile("s_waitcnt vmcnt(" #n ")" ::: "memory")
#define PG8_WAIT_L(n) asm volatile("s_waitcnt lgkmcnt(" #n ")" ::: "memory")
#define PG8_BAR __builtin_amdgcn_s_barrier()
#define PG8_SCHED __builtin_amdgcn_sched_barrier(0)
    Unit cur = S.get(0), nxt; int ui = 0;
    if (cur.nt == 0) return;
    f32x4 acc[2][2][4][2];
#pragma unroll
    for (int a = 0; a < 2; ++a)
#pragma unroll
        for (int b = 0; b < 2; ++b)
#pragma unroll
            for (int m = 0; m < 4; ++m)
#pragma unroll
                for (int n = 0; n < 2; ++n) acc[a][b][m][n] = (f32x4){0.f, 0.f, 0.f, 0.f};
    bf16x8 At[4][2], B0[2][2], B1[2][2];
    const char* cA = (const char*)g.A + (size_t)cur.pm * tstep + (size_t)cur.kofs * 2; const char* cB = (const char*)g.Bt + (size_t)cur.pn * tstep + (size_t)cur.kofs * 2;
    S.a_ready(cur);
    if constexpr (SP2) {
        PG8_STAGE(PG8_SB(0, 0), cB, voffB); PG8_STAGE(PG8_SB(0, 1), cB + hstep, voffB); PG8_STAGE(PG8_SA(0, 0), cA, voffA); PG8_STAGE(PG8_SA(0, 1), cA + hstep, voffA);
        if (wr == 1) PG8_BAR;
        PG8_WAIT_V(2); PG8_BAR;
        PG8_STAGE(PG8_SB(1, 0), cB + kstep, voffB); PG8_STAGE(PG8_SA(1, 0), cA + kstep, voffA); PG8_STAGE(PG8_SB(1, 1), cB + hstep + kstep, voffB);
        PG8_WAIT_V(6); PG8_BAR;
    } else {
        PG8_STAGE(PG8_SB(0, 0), cB, voffB); PG8_STAGE(PG8_SA(0, 0), cA, voffA); PG8_STAGE(PG8_SB(0, 1), cB + hstep, voffB); PG8_STAGE(PG8_SA(0, 1), cA + hstep, voffA);
        if (wr == 1) PG8_BAR;
        PG8_WAIT_V(4); PG8_BAR;
        PG8_STAGE(PG8_SB(1, 0), cB + kstep, voffB); PG8_STAGE(PG8_SA(1, 0), cA + kstep, voffA); PG8_STAGE(PG8_SB(1, 1), cB + hstep + kstep, voffB);
        PG8_WAIT_V(6); PG8_BAR;
    }
    for (;;) {
        nxt = S.get(ui + 1); const bool has_next = nxt.nt != 0;
        const char* nA = has_next ? (const char*)g.A + (size_t)nxt.pm * tstep + (size_t)nxt.kofs * 2 : cA; const char* nB = has_next ? (const char*)g.Bt + (size_t)nxt.pn * tstep + (size_t)nxt.kofs * 2 : cB;
        const int nt = cur.nt;
        for (int t = 0; t < nt; t += 2) {
            const bool last = (t == nt - 2);
            const char* a1 = cA + (size_t)(t + 1) * kstep;
            const char* a2 = last ? nA : cA + (size_t)(t + 2) * kstep; const char* b2 = last ? nB : cB + (size_t)(t + 2) * kstep;
            const char* a3 = a2 + kstep; const char* b3 = b2 + kstep;
            if (last && has_next) S.a_ready(nxt);
            if constexpr (SP2) {
            PG8_LDB(B0, 0, 0); PG8_LDB(B1, 0, 1); PG8_SCHED; PG8_LDA(At, 0, 0); PG8_STAGE(PG8_SA(1, 1), a1 + hstep, voffA);
            PG8_WAIT_V(8); PG8_WAIT_L(0); PG8_BAR; PG8_MMA(0, 0, At, B0); PG8_MMA(0, 1, At, B1); PG8_BAR; PG8_SCHED;
            PG8_LDA(At, 0, 1); PG8_STAGE(PG8_SB(0, 0), b2, voffB); PG8_STAGE(PG8_SB(0, 1), b2 + hstep, voffB); PG8_STAGE(PG8_SA(0, 0), a2, voffA);
            PG8_WAIT_V(8); PG8_WAIT_L(0); PG8_BAR; PG8_MMA(1, 0, At, B0); PG8_MMA(1, 1, At, B1); PG8_BAR; PG8_SCHED;
            PG8_LDB(B0, 1, 0); PG8_LDB(B1, 1, 1); PG8_SCHED; PG8_LDA(At, 1, 0); PG8_STAGE(PG8_SA(0, 1), a2 + hstep, voffA);
            PG8_WAIT_V(8); PG8_WAIT_L(0); PG8_BAR; PG8_MMA(0, 0, At, B0); PG8_MMA(0, 1, At, B1); PG8_BAR; PG8_SCHED;
            PG8_LDA(At, 1, 1); PG8_STAGE(PG8_SB(1, 0), b3, voffB); PG8_STAGE(PG8_SB(1, 1), b3 + hstep, voffB); PG8_STAGE(PG8_SA(1, 0), a3, voffA);
            PG8_WAIT_V(8); PG8_WAIT_L(0); PG8_BAR; PG8_MMA(1, 0, At, B0); PG8_MMA(1, 1, At, B1); PG8_BAR; PG8_SCHED;
            } else {
            PG8_LDB(B0, 0, 0); PG8_SCHED; PG8_LDA(At, 0, 0); PG8_STAGE(PG8_SA(1, 1), a1 + hstep, voffA);
            PG8_WAIT_L(8); PG8_BAR; PG8_WAIT_L(0); PG8_MMA(0, 0, At, B0); PG8_BAR; PG8_SCHED;
            PG8_LDB(B1, 0, 1); PG8_STAGE(PG8_SB(0, 0), b2, voffB);
            PG8_BAR; PG8_WAIT_L(0); PG8_MMA(0, 1, At, B1); PG8_BAR;
            PG8_LDA(At, 0, 1); PG8_STAGE(PG8_SA(0, 0), a2, voffA);
            PG8_BAR; PG8_WAIT_L(0); PG8_MMA(1, 0, At, B0); PG8_BAR; PG8_SCHED;
            PG8_STAGE(PG8_SB(0, 1), b2 + hstep, voffB);
            PG8_WAIT_V(6); PG8_BAR; PG8_MMA(1, 1, At, B1); PG8_BAR;
            PG8_LDB(B0, 1, 0); PG8_SCHED; PG8_LDA(At, 1, 0); PG8_STAGE(PG8_SA(0, 1), a2 + hstep, voffA);
            PG8_WAIT_L(8); PG8_BAR; PG8_WAIT_L(0); PG8_MMA(0, 0, At, B0); PG8_BAR; PG8_SCHED;
            PG8_LDB(B1, 1, 1); PG8_STAGE(PG8_SB(1, 0), b3, voffB);
            PG8_BAR; PG8_WAIT_L(0); PG8_MMA(0, 1, At, B1); PG8_BAR;
            PG8_LDA(At, 1, 1); PG8_STAGE(PG8_SA(1, 0), a3, voffA);
            PG8_BAR; PG8_WAIT_L(0); PG8_MMA(1, 0, At, B0); PG8_BAR; PG8_SCHED;
            PG8_STAGE(PG8_SB(1, 1), b3 + hstep, voffB);
            PG8_WAIT_V(6); PG8_BAR; PG8_MMA(1, 1, At, B1); PG8_BAR;
            }
        }
        if constexpr (ALIGN_EPI) { if (wr == 0) PG8_BAR; }
        if constexpr (!Epi::AFTER_DRAIN) { E(acc, cur, wr, wc, fr, fq); S.done(cur); }
        if (!has_next) break;
#pragma unroll
        for (int a = 0; a < 2; ++a)
#pragma unroll
            for (int b = 0; b < 2; ++b)
#pragma unroll
                for (int m = 0; m < 4; ++m)
#pragma unroll
                    for (int n = 0; n < 2; ++n) acc[a][b][m][n] = (f32x4){0.f, 0.f, 0.f, 0.f};
        cur = nxt; cA = nA; cB = nB; ++ui;
        if constexpr (ALIGN_EPI) { if (wr == 1) PG8_BAR; }
    }
    PG8_WAIT_V(0);
    if constexpr (!ALIGN_EPI) { if (wr == 0) PG8_BAR; }
    PG8_BAR;
    if constexpr (Epi::AFTER_DRAIN) { E.fused(acc, cur, wr, wc, fr, fq, lds, wid, lane); S.done(cur); }
#undef PG8_SA
#undef PG8_SB
#undef PG8_STAGE
#undef PG8_LDA
#undef PG8_LDB
#undef PG8_MMA
#undef PG8_WAIT_V
#undef PG8_WAIT_L
#undef PG8_BAR
#undef PG8_SCHED
}
}

constexpr int D = 1024, NIN = 2304, FF = 4096;
constexpr int NB = 8, SEQ = 8192, NPROMPT = NB * SEQ;
constexpr int SB = 16, SS = 32, NSAMP = SB * SS;
constexpr int MTOT = NPROMPT + NSAMP;
constexpr int NMETA = 16, CONVD = 512, QD = 512, KVD = 128, HD = 64;
constexpr int COL_B = 0, COL_C = 512, COL_U = 1024, COL_Q = 1536, COL_K = 2048, COL_V = 2176;
constexpr float EPS = 1e-6f;
constexpr float LOG2E = 1.4426950408889634f;
constexpr float C2 = 0.125f * LOG2E;
constexpr size_t O_YP = 0, O_YS = 67108864, O_PK = 67633152, O_PV = 67764224, O_PMK = 67895296, O_PMV = 67911680, O_PC = 67928064, O_SK = 67936256, O_SV = 68001792, O_SC = 68067328, O_END = 68083712;
constexpr size_t MiB = 1u << 20;
constexpr size_t WS_CTL = 0, CTL_ZERO_BYTES = 64 * 1024;
constexpr size_t WS_WIN = 2 * MiB, WS_WOUT = 8 * MiB, WS_WUP = 10 * MiB, WS_WDN = 18 * MiB;
constexpr size_t WS_METAPROJ = 26 * MiB;
constexpr size_t WS_METAKV = 26 * MiB + 256 * 1024;
constexpr size_t WS_SSQ = 27 * MiB;
constexpr size_t WS_XN2 = 32 * MiB;
constexpr size_t WS_XN0 = 161 * MiB;
constexpr size_t WS_PROJ = 290 * MiB;
constexpr size_t WS_MIX = 581 * MiB;
constexpr size_t WS_HID = 161 * MiB;
constexpr size_t WS_SLAB = 678 * MiB;
constexpr size_t WS_MLP = 710 * MiB;
constexpr size_t WS_END = 839 * MiB;
constexpr int DN_KSPLIT = 16;
static_assert(WS_SSQ + (size_t)MTOT * 16 * 4 <= WS_XN2 && WS_XN2 + (size_t)MTOT * D * 2 <= WS_XN0 && WS_XN0 + (size_t)MTOT * D * 2 <= WS_PROJ && WS_PROJ + (size_t)MTOT * NIN * 2 <= WS_MIX && WS_MIX + (size_t)MTOT * D * 2 <= WS_MLP && WS_MLP + (size_t)MTOT * D * 2 <= WS_END && WS_HID + (size_t)MTOT * FF * 2 <= WS_SLAB, "ws map");

constexpr int NWAVES = 8, NTHREADS = 512;
constexpr int LDS_BYTES = 147456;
constexpr int LDSCTL_OFF = 131072;

#define LAS __attribute__((address_space(3)))
typedef unsigned short bf16;
typedef unsigned v4u __attribute__((ext_vector_type(4)));
typedef float f32x4 __attribute__((ext_vector_type(4)));

__device__ __forceinline__ unsigned f2bf(float f) { unsigned u = __builtin_bit_cast(unsigned, f); return (u + 0x7fffu + ((u >> 16) & 1u)) >> 16; }
__device__ __forceinline__ unsigned pk2(float lo, float hi) { return f2bf(lo) | (f2bf(hi) << 16); }
__device__ __forceinline__ float bflo(unsigned w) { return __builtin_bit_cast(float, w << 16); }
__device__ __forceinline__ float bfhi(unsigned w) { return __builtin_bit_cast(float, w & 0xffff0000u); }
__device__ __forceinline__ float wave_sum(float v) {
#pragma unroll
    for (int o = 1; o < 64; o <<= 1) v += __shfl_xor(v, o);
    return v;
}

#define XB_TMO      128
#define XB_XCNT(j)  (256  + 64 * (j))
#define XB_XSUB(j)  (1280 + 64 * (j))
#define XB_XGEN(j)  (2304 + 64 * (j))
#define XB_TOP      3328
#define XB_TOPGEN   3392
#define XCD_BAR_WORDS 3456
#define XB_SPIN_CAP (1u << 18)

__device__ __forceinline__ unsigned xb_ld(unsigned* p)              { return __hip_atomic_load(p, __ATOMIC_RELAXED, __HIP_MEMORY_SCOPE_AGENT); }
__device__ __forceinline__ unsigned xb_add(unsigned* p, unsigned v) { return __hip_atomic_fetch_add(p, v, __ATOMIC_RELAXED, __HIP_MEMORY_SCOPE_AGENT); }
__device__ __forceinline__ unsigned xb_xcc_id() { return (unsigned)__builtin_amdgcn_s_getreg((3 << 11) | 20) & 0xFu; }
#define XB_SPIN(cond, bar) do { unsigned _sp = 0; while (cond) { __builtin_amdgcn_s_sleep(1); \
    if ((++_sp & 255u) == 0u) { if (xb_ld(&(bar)[XB_TMO])) break; if (_sp > XB_SPIN_CAP) { atomicAdd(&(bar)[XB_TMO], 1u); break; } } } } while (0)

struct XcdBarrier {
    unsigned* bar; unsigned x;
    volatile LAS unsigned* st;
};

__device__ __forceinline__ XcdBarrier xcd_barrier_post(unsigned* bar, volatile LAS unsigned* st) {
    XcdBarrier b; b.bar = bar; b.x = xb_xcc_id(); b.st = st;
    if (threadIdx.x == 0) (void)xb_add(&bar[XB_XCNT(b.x)], 1u);
    return b;
}
__device__ __forceinline__ void xcd_barrier_complete(unsigned* bar, unsigned x, unsigned& nloc, unsigned& nx) {
    const unsigned G = gridDim.x * gridDim.y * gridDim.z;
    unsigned sum, cnt, mine, sp = 0u;
    for (;;) {
        sum = 0u; cnt = 0u; mine = 0u;
#pragma unroll
        for (unsigned j = 0; j < 16; ++j) { const unsigned c = xb_ld(&bar[XB_XCNT(j)]); sum += c; cnt += (c > 0u) ? 1u : 0u; mine = (j == x) ? c : mine; }
        if (sum == G) break;
        __builtin_amdgcn_s_sleep(1);
        if ((++sp & 255u) == 0u) { if (xb_ld(&bar[XB_TMO])) break; if (sp > XB_SPIN_CAP) { atomicAdd(&bar[XB_TMO], 1u); break; } }
    }
    nloc = mine > 0u ? mine : 1u; nx = cnt > 0u ? cnt : 1u;
}

__device__ __forceinline__ void xcd_barrier(const XcdBarrier& b) {
    asm volatile("s_waitcnt vmcnt(0)" ::: "memory");
    __syncthreads();
    if (threadIdx.x == 0) {
        unsigned* bar = b.bar;
        __builtin_amdgcn_s_waitcnt(0);
        unsigned nloc = b.st[0], nx = b.st[1];
        if (nloc == 0u) { xcd_barrier_complete(bar, b.x, nloc, nx); b.st[0] = nloc; b.st[1] = nx; }
        const unsigned old = xb_add(&bar[XB_XSUB(b.x)], 1u);
        const unsigned gen = old / nloc;
        if (old + 1u == (gen + 1u) * nloc) {
            __builtin_amdgcn_fence(__ATOMIC_RELEASE, "agent");
            asm volatile("s_waitcnt vmcnt(0)" ::: "memory");
            const unsigned og = xb_add(&bar[XB_TOP], 1u);
            const unsigned tg = og / nx;
            if (og + 1u == (tg + 1u) * nx) xb_add(&bar[XB_TOPGEN], 1u);
            else XB_SPIN(xb_ld(&bar[XB_TOPGEN]) == tg, bar);
            __builtin_amdgcn_fence(__ATOMIC_ACQUIRE, "agent");
            xb_add(&bar[XB_XGEN(b.x)], 1u);
            asm volatile("s_waitcnt vmcnt(0)" ::: "memory");
        } else {
            XB_SPIN(xb_ld(&bar[XB_XGEN(b.x)]) == gen, bar);
            __builtin_amdgcn_fence(__ATOMIC_ACQUIRE, "agent");
            asm volatile("s_waitcnt vmcnt(0)" ::: "memory");
        }
    }
    __syncthreads();
}

struct Params {
    const float* in[20];
    float* out;
    unsigned char* ws;
};

typedef const __attribute__((address_space(4))) unsigned char* kargp_t;
#define KARGS() kargp_t ka_ = (kargp_t)__builtin_amdgcn_kernarg_segment_ptr(); asm volatile("" : "+s"(ka_))
#define KIN(i) (*(const float* const __attribute__((address_space(4)))*)(ka_ + 8 * (i)))
#define KOUT() (*(float* const __attribute__((address_space(4)))*)(ka_ + 160))
#define KWS() (*(unsigned char* const __attribute__((address_space(4)))*)(ka_ + 168))

__device__ __forceinline__ void p0_transpose_item(const float* W, int K, int N, bf16* WT, const float* gk, LAS float* scr, int item, int lane) {
    const int nblk = N / 32, kb = item / nblk, nb = item % nblk, k0 = 64 * kb, n0 = 32 * nb;
#pragma unroll 8
    for (int i = 0; i < 32; ++i) { const int kk = 2 * i + (lane >> 5); float v = W[(size_t)(k0 + kk) * N + n0 + (lane & 31)]; if (gk) v *= gk[k0 + kk]; scr[kk * 33 + (lane & 31)] = v; }
    asm volatile("s_waitcnt lgkmcnt(0)" ::: "memory");
    const int c = lane & 7;
#pragma unroll
    for (int j = 0; j < 4; ++j) { const int n = (lane >> 3) + 8 * j; const LAS float* s = scr + (8 * c) * 33 + n;
        v4u o; o.x = pk2(s[0 * 33], s[1 * 33]); o.y = pk2(s[2 * 33], s[3 * 33]); o.z = pk2(s[4 * 33], s[5 * 33]); o.w = pk2(s[6 * 33], s[7 * 33]);
        *(v4u*)(WT + (size_t)(n0 + n) * K + k0 + 8 * c) = o; }
    asm volatile("s_waitcnt lgkmcnt(0)" ::: "memory");
}
__device__ __forceinline__ void rms_row_to_bf16(const float* xrow, const float* g, bf16* orow, int lane) {
    const f32x4* xr = (const f32x4*)xrow + lane; const f32x4* gr = (const f32x4*)g + lane;
    f32x4 v[4]; float s = 0.f;
#pragma unroll
    for (int j = 0; j < 4; ++j) { v[j] = xr[64 * j]; s += (v[j].x * v[j].x + v[j].y * v[j].y) + (v[j].z * v[j].z + v[j].w * v[j].w); }
    const float rstd = 1.0f / sqrtf(wave_sum(s) * (1.f / D) + EPS);
    unsigned long long* o8 = (unsigned long long*)orow + lane;
#pragma unroll
    for (int j = 0; j < 4; ++j) { const f32x4 gg = gr[64 * j];
        o8[64 * j] = (unsigned long long)pk2(v[j].x * rstd * gg.x, v[j].y * rstd * gg.y) | ((unsigned long long)pk2(v[j].z * rstd * gg.z, v[j].w * rstd * gg.w) << 32); }
}

__device__ __forceinline__ int t5_bucket(int rel) {
    const int n = rel < 0 ? -rel : rel; int ret = rel > 0 ? 16 : 0;
    if (n < 8) return ret + n;
    int large = (31 - __clz(n * n)) + 2; if (large > 15) large = 15;
    return ret + large;
}


typedef float f32x16 __attribute__((ext_vector_type(16)));
typedef short bf16x8v __attribute__((ext_vector_type(8)));
typedef short v4i16_t __attribute__((ext_vector_type(4)));
template <int NQT>
__device__ __forceinline__ void attn_core(LAS unsigned char* KIMG, LAS unsigned char* VIMG, const LAS float* BREL, LAS float* SSQX, const bf16* PROJ, bf16* MIX, const float* g_attn, const float* sinks,
                                          size_t row0, int kt0, int ntiles, int metaoff, int wave, int lane, const bf16x8v (&qf)[NQT][4]) {
    const int h = wave, kvh = h >> 2, q = lane & 31, hh = lane >> 5;
    f32x16 O[NQT][2]; float m[NQT], l[NQT];
    const float sink2 = sinks[h] * LOG2E;
#pragma unroll
    for (int qt = 0; qt < NQT; ++qt) { m[qt] = sink2; l[qt] = hh == 0 ? 1.f : 0.f;
#pragma unroll
        for (int dt = 0; dt < 2; ++dt)
#pragma unroll
            for (int r = 0; r < 16; ++r) O[qt][dt][r] = 0.f; }
    const int kswz = q & 15;
    int koff[4];
#pragma unroll
    for (int ks = 0; ks < 4; ++ks) koff[ks] = q * 256 + (((kvh * 8 + ks * 2 + hh) ^ kswz) << 4);
    const int G4 = lane >> 4, i16 = lane & 15, vsw = (i16 >> 2) & 3;
    int voff[2];
#pragma unroll
    for (int dt = 0; dt < 2; ++dt) voff[dt] = (4 * (G4 >> 1) + (i16 >> 2)) * 256 + ((((kvh * 2 + dt) ^ vsw) << 6) | ((G4 & 1) * 32 + (i16 & 3) * 8));
    for (int kt = kt0; kt < ntiles; ++kt) {
        bf16x8v kf[4], vf[2][2];
#pragma unroll
        for (int ks = 0; ks < 4; ++ks) kf[ks] = *(const LAS bf16x8v*)(KIMG + kt * 8192 + koff[ks]);
#pragma unroll
        for (int dt = 0; dt < 2; ++dt)
#pragma unroll
            for (int s = 0; s < 2; ++s) {
                const v4i16_t a = __builtin_amdgcn_ds_read_tr16_b64_v4i16((LAS v4i16_t*)(VIMG + kt * 8192 + s * 4096 + voff[dt]));
                const v4i16_t bq = __builtin_amdgcn_ds_read_tr16_b64_v4i16((LAS v4i16_t*)(VIMG + kt * 8192 + s * 4096 + 2048 + voff[dt]));
                vf[dt][s] = (bf16x8v){a[0], a[1], a[2], a[3], bq[0], bq[1], bq[2], bq[3]}; }
        const bool lastt = (kt == ntiles - 1);
#pragma unroll
        for (int qt = 0; qt < NQT; ++qt) {
            f32x16 S;
#pragma unroll
            for (int r = 0; r < 16; ++r) S[r] = 0.f;
#pragma unroll
            for (int ks = 0; ks < 4; ++ks) S = __builtin_amdgcn_mfma_f32_32x32x16_bf16(kf[ks], qf[qt][ks], S, 0, 0, 0);
            const int i = 32 * qt + q;
            float tmax;
            if (!lastt) {
                const LAS float* bp = BREL + h * 256 + (32 * kt + 63 + 4 * hh - i);
#pragma unroll
                for (int r = 0; r < 16; ++r) S[r] = S[r] * C2 + bp[(r & 3) + 8 * (r >> 2)];
                tmax = S[0];
#pragma unroll
                for (int r = 1; r < 16; ++r) tmax = fmaxf(tmax, S[r]);
            } else {
#pragma unroll
                for (int r = 0; r < 8; ++r) { const int kr = (r & 3) + 8 * (r >> 2) + 4 * hh; int rel = kr - metaoff - i; rel = rel < -191 ? -191 : rel; S[r] = S[r] * C2 + BREL[h * 256 + rel + 191]; }
                tmax = S[0];
#pragma unroll
                for (int r = 1; r < 8; ++r) tmax = fmaxf(tmax, S[r]);
#pragma unroll
                for (int r = 8; r < 16; ++r) S[r] = -INFINITY;
            }
            tmax = fmaxf(tmax, __shfl_xor(tmax, 32));
            const float mn = fmaxf(m[qt], tmax), sc = __builtin_amdgcn_exp2f(m[qt] - mn); m[qt] = mn;
            float psum = 0.f;
#pragma unroll
            for (int r = 0; r < 16; ++r) { S[r] = __builtin_amdgcn_exp2f(S[r] - mn); psum += S[r]; }
            l[qt] = l[qt] * sc + psum;
#pragma unroll
            for (int dt = 0; dt < 2; ++dt)
#pragma unroll
                for (int r = 0; r < 16; ++r) O[qt][dt][r] *= sc;
            bf16x8v pf[2];
#pragma unroll
            for (int s = 0; s < 2; ++s) { v4u w; w.x = pg8::cvt_pk_bf16(S[8 * s + 0], S[8 * s + 1]); w.y = pg8::cvt_pk_bf16(S[8 * s + 2], S[8 * s + 3]); w.z = pg8::cvt_pk_bf16(S[8 * s + 4], S[8 * s + 5]); w.w = pg8::cvt_pk_bf16(S[8 * s + 6], S[8 * s + 7]);
                pf[s] = __builtin_bit_cast(bf16x8v, w); }
#pragma unroll
            for (int dt = 0; dt < 2; ++dt)
#pragma unroll
                for (int s = 0; s < 2; ++s) O[qt][dt] = __builtin_amdgcn_mfma_f32_32x32x16_bf16(vf[dt][s], pf[s], O[qt][dt], 0, 0, 0);
        }
    }
#pragma unroll
    for (int qt = 0; qt < NQT; ++qt) {
        const float lt = l[qt] + __shfl_xor(l[qt], 32), inv = 1.0f / lt; float ss = 0.f;
#pragma unroll
        for (int dt = 0; dt < 2; ++dt)
#pragma unroll
            for (int r = 0; r < 16; ++r) { O[qt][dt][r] *= inv; ss += O[qt][dt][r] * O[qt][dt][r]; }
        ss += __shfl_xor(ss, 32);
        if (hh == 0) SSQX[h * 64 + 32 * qt + q] = ss;
    }
    __syncthreads();
#pragma unroll
    for (int qt = 0; qt < NQT; ++qt) {
        float tot = 0.f;
#pragma unroll
        for (int h2 = 0; h2 < 8; ++h2) tot += SSQX[h2 * 64 + 32 * qt + q];
        const float rstd = 1.0f / sqrtf(tot * (1.f / QD) + EPS);
        bf16* mrow = MIX + (row0 + 32 * qt + q) * D + CONVD + 64 * h;
#pragma unroll
        for (int dt = 0; dt < 2; ++dt)
#pragma unroll
            for (int g4 = 0; g4 < 4; ++g4) { const int d0 = 32 * dt + 8 * g4 + 4 * hh; const f32x4 gv = *(const f32x4*)(g_attn + 64 * h + d0);
                pg8::u32x2 w; w.x = pg8::cvt_pk_bf16(O[qt][dt][4 * g4 + 0] * rstd * gv.x, O[qt][dt][4 * g4 + 1] * rstd * gv.y); w.y = pg8::cvt_pk_bf16(O[qt][dt][4 * g4 + 2] * rstd * gv.z, O[qt][dt][4 * g4 + 3] * rstd * gv.w);
                *(pg8::u32x2*)(mrow + d0) = w; }
    }
}


template <bool ISA>
__device__ __forceinline__ void p2_unit(int b, int c, LAS unsigned char* lds, kargp_t ka_, int tid, int wave, int lane) {
    unsigned char* ws = KWS(); const bf16* PROJ = (const bf16*)(ws + WS_PROJ); bf16* MIX = (bf16*)(ws + WS_MIX);
    constexpr int NQT = ISA ? 2 : 1, TPW = ISA ? 8 : 4, NIT = ISA ? 14 : 12, NTILES = ISA ? 7 : 6;
    LAS unsigned char* KIMG = lds; LAS unsigned char* VIMG = lds + 57344; const LAS float* BREL = (const LAS float*)(lds + 114688); LAS float* SSQX = (LAS float*)(lds + 114688 + 8192);
    asm volatile("" : "+v"(lane));
    const size_t row0 = ISA ? (size_t)b * SEQ + 64 * c : (size_t)NPROMPT + 32 * b;
    const int jr = tid >> 5, cc = tid & 31;
    v4u sv[NIT]; f32x4 fa[9], fb[9];
#pragma unroll
    for (int it = 0; it < NIT; ++it) { const int j = jr + 16 * it; sv[it] = (v4u){0u, 0u, 0u, 0u};
        if constexpr (ISA) {
            if (it < 12) { const int tk = 64 * (c - 2) + j; if (tk >= 0) sv[it] = *(const v4u*)(PROJ + ((size_t)b * SEQ + tk) * NIN + COL_K + 8 * cc); }
            else if (it == 12) sv[it] = *(const v4u*)((const bf16*)(ws + WS_METAKV) + (j - 192) * 256 + 8 * cc);
        } else {
            if (it < 8) { const float* src = (cc < 16 ? KIN(2) : KIN(3)) + ((size_t)b * 128 + j) * 128 + 8 * (cc & 15); fa[it] = *(const f32x4*)src; fb[it] = *(const f32x4*)(src + 4); }
            else if (it < 10) sv[it] = *(const v4u*)(PROJ + (row0 + (j - 128)) * NIN + COL_K + 8 * cc);
            else if (it == 10) { const float* src = (cc < 16 ? KIN(4) : KIN(5)) + ((size_t)b * 16 + (j - 160)) * 128 + 8 * (cc & 15); fa[8] = *(const f32x4*)src; fb[8] = *(const f32x4*)(src + 4); }
        } }
    {
        const int ch = 8 * lane; const float* conv_w = KIN(10); const float* g_conv = KIN(13); float* out = KOUT();
        float w0[8], w1[8], w2[8], gc[8];
#pragma unroll
        for (int e = 0; e < 8; ++e) { w0[e] = conv_w[ch + e]; w1[e] = conv_w[CONVD + ch + e]; w2[e] = conv_w[2 * CONVD + ch + e]; gc[e] = g_conv[ch + e]; }
#pragma unroll 1
        for (int hb = 0; hb < TPW / 4; ++hb) {
            const int tb = TPW * wave + 4 * hb;
            v4u cw[6], uw[6], bw[4];
#pragma unroll
            for (int k = 0; k < 6; ++k) { const int t = tb + k - 2; const int tg = ISA ? 64 * c + t : t; cw[k] = (v4u){0u, 0u, 0u, 0u}; uw[k] = cw[k];
                if (tg >= 0) { const bf16* pr = PROJ + (ISA ? (size_t)b * SEQ + tg : (size_t)NPROMPT + 32 * b + tg) * NIN; cw[k] = *(const v4u*)(pr + COL_C + ch); uw[k] = *(const v4u*)(pr + COL_U + ch); } }
#pragma unroll
            for (int k = 0; k < 4; ++k) bw[k] = *(const v4u*)(PROJ + (row0 + tb + k) * NIN + COL_B + ch);
            float ua[8] = {0.f, 0.f, 0.f, 0.f, 0.f, 0.f, 0.f, 0.f}, ub[8] = {0.f, 0.f, 0.f, 0.f, 0.f, 0.f, 0.f, 0.f}, uc[8];
#pragma unroll
            for (int k = 0; k < 6; ++k) {
                const int t = tb + k - 2;
                const int tg = ISA ? 64 * c + t : t;
                if (tg >= 0) { const v4u a = cw[k], bq = uw[k];
                    uc[0] = bflo(a.x) * bflo(bq.x); uc[1] = bfhi(a.x) * bfhi(bq.x); uc[2] = bflo(a.y) * bflo(bq.y); uc[3] = bfhi(a.y) * bfhi(bq.y);
                    uc[4] = bflo(a.z) * bflo(bq.z); uc[5] = bfhi(a.z) * bfhi(bq.z); uc[6] = bflo(a.w) * bflo(bq.w); uc[7] = bfhi(a.w) * bfhi(bq.w); }
                else if (ISA) { const float* mp = (const float*)(ws + WS_METAPROJ) + (size_t)(16 + tg) * NIN;
#pragma unroll
                    for (int e = 0; e < 8; ++e) uc[e] = mp[COL_C + ch + e] * mp[COL_U + ch + e]; }
                else { const float* sp = KIN(6) + ((size_t)b * 2 + (2 + tg)) * CONVD + ch;
#pragma unroll
                    for (int e = 0; e < 8; ++e) uc[e] = sp[e]; }
                if (k >= 2) {
                    const size_t row = row0 + t; const v4u bq = bw[k - 2];
                    const float bv[8] = {bflo(bq.x), bfhi(bq.x), bflo(bq.y), bfhi(bq.y), bflo(bq.z), bfhi(bq.z), bflo(bq.w), bfhi(bq.w)};
                    float y[8]; float ss = 0.f;
#pragma unroll
                    for (int e = 0; e < 8; ++e) { y[e] = bv[e] * (w0[e] * ua[e] + w1[e] * ub[e] + w2[e] * uc[e]); ss += y[e] * y[e]; }
                    const float rstd = 1.0f / sqrtf(wave_sum(ss) * (1.f / CONVD) + EPS);
                    v4u w; w.x = pk2(y[0] * rstd * gc[0], y[1] * rstd * gc[1]); w.y = pk2(y[2] * rstd * gc[2], y[3] * rstd * gc[3]); w.z = pk2(y[4] * rstd * gc[4], y[5] * rstd * gc[5]); w.w = pk2(y[6] * rstd * gc[6], y[7] * rstd * gc[7]);
                    *(v4u*)(MIX + row * D + ch) = w;
                    const int last = ISA ? (c == SEQ / 64 - 1 ? 64 : 1 << 30) : 32;
                    if (t >= last - 2) { float* dst = (ISA ? out + O_PC + ((size_t)b * 2 + (t - (last - 2))) * CONVD : out + O_SC + ((size_t)b * 2 + (t - (last - 2))) * CONVD) + ch;
#pragma unroll
                        for (int e = 0; e < 8; ++e) dst[e] = uc[e]; }
                }
#pragma unroll
                for (int e = 0; e < 8; ++e) { ua[e] = ub[e]; ub[e] = uc[e]; }
            }
        }
    }
    bf16x8v qf[NQT][4];
    { const int q = lane & 31, hh = lane >> 5;
#pragma unroll
      for (int qt = 0; qt < NQT; ++qt)
#pragma unroll
          for (int ks = 0; ks < 4; ++ks) qf[qt][ks] = *(const bf16x8v*)(PROJ + (row0 + 32 * qt + q) * NIN + COL_Q + 64 * wave + 16 * ks + 8 * hh); }
    if (ISA) { if (c >= 126) { float* out = KOUT(); for (int o = tid; o < 64 * 256; o += NTHREADS) { const int i = o >> 8, col = o & 255; const float v = __builtin_bit_cast(float, (unsigned)PROJ[(row0 + i) * NIN + COL_K + col] << 16); const int t = 64 * (c - 126) + i;
            if (col < 128) out[O_PK + ((size_t)b * 128 + t) * 128 + col] = v; else out[O_PV + ((size_t)b * 128 + t) * 128 + (col - 128)] = v; } } }
    else { float* out = KOUT(); for (int o = tid; o < 32 * 256; o += NTHREADS) { const int i = o >> 8, col = o & 255; const float v = __builtin_bit_cast(float, (unsigned)PROJ[(row0 + i) * NIN + COL_K + col] << 16);
            if (col < 128) out[O_SK + ((size_t)b * 32 + i) * 128 + col] = v; else out[O_SV + ((size_t)b * 32 + i) * 128 + (col - 128)] = v; } }
    __syncthreads();
#pragma unroll
    for (int it = 0; it < NIT; ++it) { const int j = jr + 16 * it; v4u val = sv[it];
        if constexpr (!ISA) { if (it < 8 || it == 10) { const f32x4 a = fa[it < 8 ? it : 8], bb = fb[it < 8 ? it : 8]; val.x = pk2(a.x, a.y); val.y = pk2(a.z, a.w); val.z = pk2(bb.x, bb.y); val.w = pk2(bb.z, bb.w); } }
        if (cc < 16) *(LAS v4u*)(KIMG + j * 256 + ((cc ^ (j & 15)) << 4)) = val;
        else { const int c2 = cc - 16; *(LAS v4u*)(VIMG + j * 256 + (((((c2 >> 2) ^ (j & 3)) << 2) | (c2 & 3)) << 4)) = val; } }
    __syncthreads();
    attn_core<NQT>(KIMG, VIMG, BREL, SSQX, PROJ, MIX, KIN(14), KIN(11), row0, ISA ? (c >= 2 ? 0 : 4 - 2 * c) : 0, NTILES, ISA ? 16 + 64 * c : 16 + 4096, wave, lane, qf);
}

__global__ void __launch_bounds__(NTHREADS, 2) fwd_kernel(Params p) {
    extern __shared__ __attribute__((aligned(16))) unsigned char lds_raw[];
    LAS unsigned char* lds = (LAS unsigned char*)lds_raw;
#define TIDVARS() int tid = threadIdx.x; asm volatile("" : "+v"(tid)); const int lane = tid & 63, wave = __builtin_amdgcn_readfirstlane(tid >> 6); (void)lane; (void)wave
    const int G = gridDim.x, bid = blockIdx.x;
    if (threadIdx.x < 16) ((LAS unsigned*)(lds + LDSCTL_OFF))[threadIdx.x] = 0u;
    __syncthreads();
    const XcdBarrier bar = xcd_barrier_post((unsigned*)(*(unsigned char* const __attribute__((address_space(4)))*)((const __attribute__((address_space(4))) unsigned char*)__builtin_amdgcn_kernarg_segment_ptr() + 168) + WS_CTL) + 1024, (volatile LAS unsigned*)(lds + LDSCTL_OFF));
    {
        TIDVARS(); KARGS(); unsigned char* ws = KWS(); float* out = KOUT();
        const float* x_prompt = KIN(0); const float* x_sample = KIN(1); const float* meta_tokens = KIN(7); const float* g_mix = KIN(8); const float* w_in = KIN(9);
        const float* w_out = KIN(15); const float* g_mlp = KIN(16); const float* w_up = KIN(17); const float* w_down = KIN(18);
        bf16* WinT = (bf16*)(ws + WS_WIN); bf16* WoutT = (bf16*)(ws + WS_WOUT); bf16* WupT = (bf16*)(ws + WS_WUP); bf16* WdnT = (bf16*)(ws + WS_WDN);
        float* METAPROJ = (float*)(ws + WS_METAPROJ); bf16* METAKV = (bf16*)(ws + WS_METAKV); bf16* XN0 = (bf16*)(ws + WS_XN0);
        if (bid < NIN / 64) {
            LAS float* xnT = (LAS float*)lds;
            LAS float* red = (LAS float*)(lds + 65536);
            for (int rr = 0; rr < 2; ++rr) { const int r = 2 * wave + rr; const f32x4* xr = (const f32x4*)(meta_tokens + (size_t)r * D) + lane; const f32x4* gr = (const f32x4*)g_mix + lane;
                f32x4 v[4]; float s = 0.f;
#pragma unroll
                for (int j = 0; j < 4; ++j) { v[j] = xr[64 * j]; s += (v[j].x * v[j].x + v[j].y * v[j].y) + (v[j].z * v[j].z + v[j].w * v[j].w); }
                const float rstd = 1.0f / sqrtf(wave_sum(s) * (1.f / D) + EPS);
#pragma unroll
                for (int j = 0; j < 4; ++j) { const f32x4 gg = gr[64 * j]; const int k = 4 * lane + 256 * j;
                    xnT[(k + 0) * 16 + r] = v[j].x * rstd * gg.x; xnT[(k + 1) * 16 + r] = v[j].y * rstd * gg.y; xnT[(k + 2) * 16 + r] = v[j].z * rstd * gg.z; xnT[(k + 3) * 16 + r] = v[j].w * rstd * gg.w; } }
            __syncthreads();
            const int n = 64 * bid + lane; float acc[16];
#pragma unroll
            for (int r = 0; r < 16; ++r) acc[r] = 0.f;
            for (int k0 = 128 * wave; k0 < 128 * wave + 128; k0 += 8) { float wv[8];
#pragma unroll
                for (int kk = 0; kk < 8; ++kk) wv[kk] = w_in[(size_t)(k0 + kk) * NIN + n];
#pragma unroll
                for (int kk = 0; kk < 8; ++kk) { const LAS f32x4* xs = (const LAS f32x4*)(xnT + (k0 + kk) * 16);
#pragma unroll
                    for (int q = 0; q < 4; ++q) { const f32x4 xv = xs[q]; acc[4 * q + 0] += xv.x * wv[kk]; acc[4 * q + 1] += xv.y * wv[kk]; acc[4 * q + 2] += xv.z * wv[kk]; acc[4 * q + 3] += xv.w * wv[kk]; } } }
#pragma unroll
            for (int r = 0; r < 16; ++r) red[(wave * 16 + r) * 64 + lane] = acc[r];
            __syncthreads();
            for (int o = tid; o < 1024; o += NTHREADS) { const int r = o >> 6, l = o & 63; float s = 0.f;
#pragma unroll
                for (int w = 0; w < 8; ++w) s += red[(w * 16 + r) * 64 + l];
                const int nn = 64 * bid + l; METAPROJ[r * NIN + nn] = s;
                if (nn >= COL_K) { const int kc = nn - COL_K; METAKV[r * 256 + kc] = (bf16)f2bf(s);
                    float* dst = (kc < 128) ? out + O_PMK + r * 128 + kc : out + O_PMV + r * 128 + (kc - 128);
#pragma unroll
                    for (int b = 0; b < NB; ++b) dst[(size_t)b * NMETA * 128] = s; } }
            __syncthreads();
        }
        LAS float* scr = (LAS float*)(lds + wave * 16384);
        const int gw = bid * NWAVES + wave, NGW = G * NWAVES;
        constexpr int I_IN = (D / 64) * (NIN / 32), I_OUT = (D / 64) * (D / 32), I_UP = (D / 64) * (FF / 32), I_DN = (FF / 64) * (D / 32);
        constexpr int NITEMS = I_IN + I_OUT + I_UP + I_DN;
        for (int it = gw; it < NITEMS; it += NGW) {
            int r = it;
            if (r < I_IN) { p0_transpose_item(w_in, D, NIN, WinT, nullptr, scr, r, lane); continue; } r -= I_IN;
            if (r < I_OUT) { p0_transpose_item(w_out, D, D, WoutT, nullptr, scr, r, lane); continue; } r -= I_OUT;
            if (r < I_UP) { p0_transpose_item(w_up, D, FF, WupT, g_mlp, scr, r, lane); continue; } r -= I_UP;
            p0_transpose_item(w_down, FF, D, WdnT, nullptr, scr, r, lane);
        }
        {
            const int nmw = (NIN / 64) * NWAVES; int m0, m1;
            if (G == 256) { m0 = gw < nmw ? gw * 16 : nmw * 16 + (gw - nmw) * 35; m1 = m0 + (gw < nmw ? 16 : 35); } else { const int per = (MTOT + NGW - 1) / NGW; m0 = gw * per; m1 = m0 + per; }
            if (m1 > MTOT) m1 = MTOT;
            for (int m = m0; m < m1; ++m) {
                const float* xrow = (m < NPROMPT) ? x_prompt + (size_t)m * D : x_sample + (size_t)(m - NPROMPT) * D;
                rms_row_to_bf16(xrow, g_mix, XN0 + (size_t)m * D, lane);
            }
        }
    }
    xcd_barrier(bar);

    {
        KARGS(); unsigned char* ws = KWS(); bf16* WinT = (bf16*)(ws + WS_WIN); bf16* XN0 = (bf16*)(ws + WS_XN0); bf16* PROJ = (bf16*)(ws + WS_PROJ);
        pg8::Gemm g{XN0, WinT, MTOT, NIN, D}; typedef pg8::PhaseOrder<NPROMPT / 256, NSAMP / 256, NIN, D, 1> Ord; Ord S; S.init(G, bid);
        pg8::EpiProj E{PROJ, NIN};
        pg8::gemm_phase<pg8::EpiProj, Ord, true, true>(lds, g, S, E);
    }
    xcd_barrier(bar);

    {
        TIDVARS(); KARGS(); const float* rel_table = KIN(12);
        LAS unsigned char* KIMG = lds;
        LAS unsigned char* VIMG = lds + 57344;
        LAS float* BREL = (LAS float*)(lds + 114688);
        LAS float* SSQX = (LAS float*)(lds + 114688 + 8192);
        for (int o = tid; o < 8 * 256; o += NTHREADS) { const int h = o >> 8, idx = o & 255; const int rel = idx - 191; BREL[o] = (idx < 255) ? rel_table[t5_bucket(rel) * 8 + h] * LOG2E : 0.f; }
        __syncthreads();
        const int NUNITS = NB * (SEQ / 64) + SB;
        const int vcu = (G % 8 == 0) ? (bid % 8) * (G / 8) + bid / 8 : bid;
        for (int u = vcu; u < NUNITS; u += G) {
            if (u < NB * (SEQ / 64)) p2_unit<true>(u / (SEQ / 64), u % (SEQ / 64), lds, ka_, tid, wave, lane);
            else p2_unit<false>(u - NB * (SEQ / 64), 0, lds, ka_, tid, wave, lane);
        }
    }
    xcd_barrier(bar);

    {
        KARGS(); unsigned char* ws = KWS(); const float* x_prompt = KIN(0); const float* x_sample = KIN(1);
        bf16* WoutT = (bf16*)(ws + WS_WOUT); bf16* MIX = (bf16*)(ws + WS_MIX); bf16* XN2 = (bf16*)(ws + WS_XN2); float* SSQ = (float*)(ws + WS_SSQ);
        pg8::Gemm g{MIX, WoutT, MTOT, D, D}; typedef pg8::PhaseOrder<NPROMPT / 256, NSAMP / 256, D, D, 1> Ord; Ord S; S.init(G, bid);
        pg8::EpiOut E{x_prompt, x_sample, XN2, SSQ, NPROMPT};
        pg8::gemm_phase<pg8::EpiOut, Ord, true, true>(lds, g, S, E);
    }
    xcd_barrier(bar);

    {
        KARGS(); unsigned char* ws = KWS(); bf16* WupT = (bf16*)(ws + WS_WUP); bf16* XN2 = (bf16*)(ws + WS_XN2); bf16* HID = (bf16*)(ws + WS_HID);
        pg8::Gemm g{XN2, WupT, MTOT, FF, D}; typedef pg8::PhaseOrder<NPROMPT / 256, NSAMP / 256, FF, D, 1> Ord; Ord S; S.init(G, bid);
        pg8::EpiUp E{HID, FF};
        pg8::gemm_phase<pg8::EpiUp, Ord, true, true>(lds, g, S, E);
    }
    xcd_barrier(bar);

    {
        KARGS(); unsigned char* ws = KWS(); bf16* WdnT = (bf16*)(ws + WS_WDN); bf16* HID = (bf16*)(ws + WS_HID);
        pg8::Gemm g{HID, WdnT, MTOT, D, FF}; typedef pg8::PhaseOrder<NPROMPT / 256, NSAMP / 256, D, FF, DN_KSPLIT> Ord; Ord S; S.init(G, bid);
        pg8::EpiDown E{(bf16*)(ws + WS_MLP), (float*)(ws + WS_SLAB), NPROMPT / 256, NSAMP};
        pg8::gemm_phase<pg8::EpiDown, Ord, true, true>(lds, g, S, E);
    }
    xcd_barrier(bar);

    {
        TIDVARS(); KARGS(); unsigned char* ws = KWS(); float* out = KOUT(); const float* g_final = KIN(19);
        const bf16* XN2 = (const bf16*)(ws + WS_XN2); const bf16* MLP = (const bf16*)(ws + WS_MLP); const float* SSQ = (const float*)(ws + WS_SSQ); const float* SLAB = (const float*)(ws + WS_SLAB);
        const int gw = bid * NWAVES + wave, NGW = G * NWAVES;
        for (int m = gw; m < MTOT; m += NGW) {
            const v4u h0 = *((const v4u*)(XN2 + (size_t)m * D) + lane), h1 = *((const v4u*)(XN2 + (size_t)m * D) + 64 + lane);
            float ssq1 = (lane < 16) ? SSQ[(size_t)m * 16 + lane] : 0.f;
            float a[16];
            if (m < NPROMPT) {
                const v4u m0 = *((const v4u*)(MLP + (size_t)m * D) + lane), m1 = *((const v4u*)(MLP + (size_t)m * D) + 64 + lane);
                a[0] = bflo(m0.x); a[1] = bfhi(m0.x); a[2] = bflo(m0.y); a[3] = bfhi(m0.y); a[4] = bflo(m0.z); a[5] = bfhi(m0.z); a[6] = bflo(m0.w); a[7] = bfhi(m0.w);
                a[8] = bflo(m1.x); a[9] = bfhi(m1.x); a[10] = bflo(m1.y); a[11] = bfhi(m1.y); a[12] = bflo(m1.z); a[13] = bfhi(m1.z); a[14] = bflo(m1.w); a[15] = bfhi(m1.w);
            } else {
#pragma unroll
                for (int e = 0; e < 16; ++e) a[e] = 0.f;
                const float* sl = SLAB + (size_t)(m - NPROMPT) * D + 8 * lane;
                for (int ks = 0; ks < DN_KSPLIT; ++ks, sl += (size_t)NSAMP * D) { const f32x4 s0 = *(const f32x4*)sl, s1 = *(const f32x4*)(sl + 4), s2 = *(const f32x4*)(sl + 512), s3 = *(const f32x4*)(sl + 516);
                    a[0] += s0.x; a[1] += s0.y; a[2] += s0.z; a[3] += s0.w; a[4] += s1.x; a[5] += s1.y; a[6] += s1.z; a[7] += s1.w;
                    a[8] += s2.x; a[9] += s2.y; a[10] += s2.z; a[11] += s2.w; a[12] += s3.x; a[13] += s3.y; a[14] += s3.z; a[15] += s3.w; } }
            const float r2 = 1.0f / (wave_sum(ssq1) * (1.f / D) + EPS);
            float h[16] = {bflo(h0.x), bfhi(h0.x), bflo(h0.y), bfhi(h0.y), bflo(h0.z), bfhi(h0.z), bflo(h0.w), bfhi(h0.w), bflo(h1.x), bfhi(h1.x), bflo(h1.y), bfhi(h1.y), bflo(h1.z), bfhi(h1.z), bflo(h1.w), bfhi(h1.w)};
            float s = 0.f;
#pragma unroll
            for (int e = 0; e < 16; ++e) { h[e] += r2 * a[e]; s += h[e] * h[e]; }
            const float rstd = 1.0f / sqrtf(wave_sum(s) * (1.f / D) + EPS);
            const f32x4* gp = (const f32x4*)(g_final + 8 * lane); const f32x4 g0 = gp[0], g1 = gp[1], g2 = gp[128], g3 = gp[129];
            f32x4* op = (f32x4*)(out + (size_t)m * D + 8 * lane);
            op[0] = (f32x4){h[0] * rstd * g0.x, h[1] * rstd * g0.y, h[2] * rstd * g0.z, h[3] * rstd * g0.w};
            op[1] = (f32x4){h[4] * rstd * g1.x, h[5] * rstd * g1.y, h[6] * rstd * g1.z, h[7] * rstd * g1.w};
            op[128] = (f32x4){h[8] * rstd * g2.x, h[9] * rstd * g2.y, h[10] * rstd * g2.z, h[11] * rstd * g2.w};
            op[129] = (f32x4){h[12] * rstd * g3.x, h[13] * rstd * g3.y, h[14] * rstd * g3.z, h[15] * rstd * g3.w};
        }
    }
}

extern "C" void kernel_launch(void* const* d_in, const int* in_sizes, int n_in, void* d_out, int out_size, void* d_ws, size_t ws_size, hipStream_t stream) {
    static int grid = 0;
    if (grid == 0) {
        if (n_in != 20 || in_sizes[0] != NPROMPT * D || out_size != (int)O_END || ws_size < WS_END) { fprintf(stderr, "kernel_launch: unexpected shapes (n_in %d, in0 %d, out %d, ws %zu)\n", n_in, n_in > 0 ? in_sizes[0] : -1, out_size, ws_size); grid = -1; return; }
        int dev = 0, cus = 0, per_cu = 0;
        if (hipGetDevice(&dev) != hipSuccess || hipDeviceGetAttribute(&cus, hipDeviceAttributeMultiprocessorCount, dev) != hipSuccess) { grid = -1; return; }
        if (hipFuncSetAttribute((const void*)fwd_kernel, hipFuncAttributeMaxDynamicSharedMemorySize, LDS_BYTES) != hipSuccess) { fprintf(stderr, "kernel_launch: hipFuncSetAttribute failed\n"); grid = -1; return; }
        if (hipOccupancyMaxActiveBlocksPerMultiprocessor(&per_cu, (const void*)fwd_kernel, NTHREADS, LDS_BYTES) != hipSuccess || per_cu < 1) { fprintf(stderr, "kernel_launch: occupancy query says %d blocks per CU\n", per_cu); (void)hipGetLastError(); grid = -1; return; }
        grid = cus;
    }
    if (grid < 0) return;
    Params p{};
    for (int i = 0; i < 20; ++i) p.in[i] = (const float*)d_in[i];
    p.out = (float*)d_out; p.ws = (unsigned char*)d_ws;
    if (hipMemsetAsync((char*)d_ws + WS_CTL, 0, CTL_ZERO_BYTES, stream) != hipSuccess) { fprintf(stderr, "kernel_launch: memset failed\n"); return; }
    hipLaunchKernelGGL(fwd_kernel, dim3(grid), dim3(NTHREADS), LDS_BYTES, stream, p);
    const hipError_t e = hipPeekAtLastError();
    if (e != hipSuccess) fprintf(stderr, "kernel_launch: launch failed: %s (grid %d)\n", hipGetErrorString(e), grid);
}
```
